# Optimizing an MI355X kernel written in HIP

```python
import jax
import jax.numpy as jnp
from jax import lax
import numpy as np

D_MODEL = 1024
BATCH = 2
SEQ = 8192
DEPTH = 1

DSA_PATTERNS = ((128, 1), (512, 4), (2048, 16))
DSA_GROUPS = 3
DSA_HEADS = 8
DSA_HEAD_DIM = 64
DSA_WIDTH = DSA_HEADS * DSA_HEAD_DIM
DSA_BLOCK = 128
ROPE_THETA = 10000.0

GDN_HEADS = 8
GDN_KEY_DIM = 64
GDN_VAL_DIM = 64
GDN_K_WIDTH = GDN_HEADS * GDN_KEY_DIM
GDN_V_WIDTH = GDN_HEADS * GDN_VAL_DIM
GDN_CONV = 4
GDN_CHUNK = 64

NORM_EPS = 1e-6

IN_SIZES = (
    DSA_GROUPS * 3 * DSA_WIDTH,
    DSA_WIDTH,
    2 * GDN_K_WIDTH + GDN_V_WIDTH,
    GDN_V_WIDTH,
    GDN_HEADS,
    GDN_HEADS,
    D_MODEL,
    D_MODEL,
)
IN_WIDTH = sum(IN_SIZES)

kernel_name = 'hybrid_dilated_attn_gated_deltanet_block'


def _rmsnorm(x, w):
    xf = x.astype(jnp.float32)
    y = xf * lax.rsqrt(jnp.mean(xf * xf, axis=-1, keepdims=True) + NORM_EPS)
    return (y * w.astype(jnp.float32)).astype(x.dtype)


def _l2norm(t):
    return t * lax.rsqrt(jnp.sum(t * t, axis=-1, keepdims=True) + NORM_EPS)


def _split_columns(h):
    parts, start = [], 0
    for size in IN_SIZES:
        parts.append(h[..., start:start + size])
        start += size
    return parts


def _rope_tables(seq, dim):
    inv_freq = ROPE_THETA ** (-jnp.arange(0, dim, 2, dtype=jnp.float32) / dim)
    ang = jnp.arange(seq, dtype=jnp.float32)[:, None] * inv_freq[None, :]
    ang = jnp.concatenate([ang, ang], axis=-1)
    return jnp.cos(ang), jnp.sin(ang)


def _apply_rope(t, cos, sin):
    half = t.shape[-1] // 2
    rot = jnp.concatenate([-t[..., half:], t[..., :half]], axis=-1)
    return t * cos[:, None, None, :] + rot * sin[:, None, None, :]


def _dilated_window_attention(q, k, v, window, dilation):
    b, s, h, dh = q.shape
    n_back = window // dilation
    sub_len = s // dilation
    n_blk = -(-sub_len // DSA_BLOCK)
    pad = n_blk * DSA_BLOCK - sub_len

    def to_blocks(t):
        t = t.reshape(b, sub_len, dilation, h, dh).transpose(0, 2, 1, 3, 4)
        t = jnp.pad(t, ((0, 0), (0, 0), (0, pad), (0, 0), (0, 0)))
        return t.reshape(b, dilation, n_blk, DSA_BLOCK, h, dh)

    def with_previous_block(t):
        prev = jnp.pad(t, ((0, 0), (0, 0), (1, 0), (0, 0), (0, 0), (0, 0)))[:, :, :-1]
        return jnp.concatenate([prev, t], axis=3)

    qb = to_blocks(q)
    kb = with_previous_block(to_blocks(k))
    vb = with_previous_block(to_blocks(v))
    scores = jnp.einsum('brnqhd,brnkhd->brnhqk', qb, kb) * (dh ** -0.5)
    qi = jnp.arange(DSA_BLOCK)[:, None]
    kj = jnp.arange(2 * DSA_BLOCK)[None, :]
    dist = qi + DSA_BLOCK - kj
    key_idx = jnp.arange(n_blk)[:, None, None] * DSA_BLOCK + kj - DSA_BLOCK
    valid = (dist >= 0) & (dist <= n_back) & (key_idx >= 0)
    scores = jnp.where(valid[:, None], scores, -jnp.inf)
    m = jnp.max(scores, axis=-1, keepdims=True)
    p = jnp.exp(scores - m)
    den = jnp.sum(p, axis=-1, keepdims=True)
    o = jnp.einsum('brnhqk,brnkhd->brnqhd', p / den, vb)
    lse = (m + jnp.log(den))[..., 0].transpose(0, 1, 2, 4, 3)

    def from_blocks(t):
        t = t.reshape(b, dilation, n_blk * DSA_BLOCK, *t.shape[4:])[:, :, :sub_len]
        t = jnp.moveaxis(t, 1, 2)
        return t.reshape(b, s, *t.shape[3:])

    return from_blocks(o), from_blocks(lse)


def _dilated_mixture(q, k, v):
    outs, lses = [], []
    for g, (window, dilation) in enumerate(DSA_PATTERNS):
        o, lse = _dilated_window_attention(q[:, :, g], k[:, :, g], v[:, :, g], window, dilation)
        outs.append(o)
        lses.append(lse)
    wts = jax.nn.softmax(jnp.stack(lses), axis=0)
    o = jnp.einsum('gbsh,gbshd->bshd', wts, jnp.stack(outs))
    return o.reshape(o.shape[0], o.shape[1], -1)


def _causal_depthwise_conv(x, w):
    k, c = w.shape
    return lax.conv_general_dilated(
        x, w[:, None, :].astype(x.dtype), window_strides=(1,), padding=((k - 1, 0),),
        dimension_numbers=('NWC', 'WIO', 'NWC'), feature_group_count=c)


def _gated_delta_rule(q, k, v, g, beta):
    b, s, h, dk = q.shape
    dv = v.shape[-1]
    c = GDN_CHUNK
    n = s // c

    def chunk(t):
        return t.reshape(b, n, c, h, -1).transpose(0, 3, 1, 2, 4)

    qc, kc, vc = chunk(q), chunk(k), chunk(v)
    gc = g.reshape(b, n, c, h).transpose(0, 3, 1, 2)
    bc = beta.reshape(b, n, c, h).transpose(0, 3, 1, 2)
    G = jnp.cumsum(gc, axis=-1)
    causal = jnp.tril(jnp.ones((c, c), dtype=bool))
    strict = jnp.tril(jnp.ones((c, c), dtype=bool), k=-1)
    decay_incl = jnp.exp(jnp.where(causal, G[..., :, None] - G[..., None, :], -jnp.inf))
    decay_strict = jnp.where(strict, decay_incl, 0.0)
    k_beta = kc * bc[..., None]
    a = jnp.einsum('bhnid,bhnjd->bhnij', k_beta, kc) * decay_strict
    eye = jnp.eye(c, dtype=a.dtype)
    t_inv = lax.linalg.triangular_solve(eye + a, jnp.broadcast_to(eye, a.shape),
                                        left_side=True, lower=True, unit_diagonal=True)
    u = t_inv @ (vc * bc[..., None])
    w = t_inv @ (k_beta * jnp.exp(G)[..., None])
    attn = jnp.einsum('bhnid,bhnjd->bhnij', qc, kc) * decay_incl
    q_dec = qc * jnp.exp(G)[..., None]
    g_last = G[..., -1:]
    k_dec = kc * jnp.exp(g_last - G)[..., None]
    chunk_decay = jnp.exp(g_last[..., 0])
    xs = tuple(jnp.moveaxis(t, 2, 0) for t in (q_dec, attn, u, w, k_dec, chunk_decay))

    def step(state, inp):
        q_e, at, u_c, w_c, k_d, dec = inp
        v_new = u_c - jnp.einsum('bhck,bhkv->bhcv', w_c, state)
        o = jnp.einsum('bhck,bhkv->bhcv', q_e, state) + jnp.einsum('bhij,bhjv->bhiv', at, v_new)
        state = state * dec[..., None, None] + jnp.einsum('bhck,bhcv->bhkv', k_d, v_new)
        return state, o

    state0 = jnp.zeros((b, h, dk, dv), dtype=q.dtype)
    _, o = lax.scan(step, state0, xs)
    return o.transpose(1, 0, 3, 2, 4).reshape(b, s, h, dv)


def setup_inputs(seed: int = 0) -> dict:
    key = jax.random.key(seed)
    ks = jax.random.split(key, 12)
    f32 = jnp.float32
    x = jax.random.normal(ks[0], (BATCH, SEQ, D_MODEL), f32)
    norm_w = 1.0 + 0.05 * jax.random.normal(ks[1], (DEPTH, D_MODEL), f32)
    w_in = jax.random.normal(ks[2], (DEPTH, D_MODEL, IN_WIDTH), f32) * D_MODEL ** -0.5
    conv_w = jax.random.normal(ks[3], (DEPTH, GDN_CONV, 2 * GDN_K_WIDTH + GDN_V_WIDTH), f32) * GDN_CONV ** -0.5
    a_log = jnp.log(jax.random.uniform(ks[4], (DEPTH, GDN_HEADS), f32, 1.0, 16.0))
    dt_bias = 0.5 * jax.random.normal(ks[5], (DEPTH, GDN_HEADS), f32)
    gdn_norm_w = 1.0 + 0.05 * jax.random.normal(ks[6], (DEPTH, GDN_VAL_DIM), f32)
    w_up_a = jax.random.normal(ks[7], (DEPTH, DSA_WIDTH, D_MODEL), f32) * DSA_WIDTH ** -0.5
    w_up_b = jax.random.normal(ks[8], (DEPTH, GDN_V_WIDTH, D_MODEL), f32) * GDN_V_WIDTH ** -0.5
    w_out = jax.random.normal(ks[9], (DEPTH, D_MODEL, D_MODEL), f32) * D_MODEL ** -0.5
    final_norm_w = 1.0 + 0.05 * jax.random.normal(ks[10], (D_MODEL,), f32)
    return {'x': x, 'norm_w': norm_w, 'w_in': w_in, 'conv_w': conv_w, 'a_log': a_log,
            'dt_bias': dt_bias, 'gdn_norm_w': gdn_norm_w, 'w_up_a': w_up_a, 'w_up_b': w_up_b,
            'w_out': w_out, 'final_norm_w': final_norm_w}


def reference(x, norm_w, w_in, conv_w, a_log, dt_bias, gdn_norm_w, w_up_a, w_up_b, w_out, final_norm_w):
    f32 = jnp.float32
    b, s, _ = x.shape
    cos, sin = _rope_tables(s, DSA_HEAD_DIM)
    for layer in range(DEPTH):
        h = _rmsnorm(x, norm_w[layer])
        proj = h @ w_in[layer]
        dsa_qkv, dsa_z, gdn_qkv, gdn_z, gdn_b, gdn_a, gate_a, gate_b = _split_columns(proj)

        qkv = dsa_qkv.astype(f32).reshape(b, s, DSA_GROUPS, 3, DSA_HEADS, DSA_HEAD_DIM)
        q_a = _apply_rope(qkv[:, :, :, 0], cos, sin)
        k_a = _apply_rope(qkv[:, :, :, 1], cos, sin)
        v_a = qkv[:, :, :, 2]
        o_a = _dilated_mixture(q_a, k_a, v_a).astype(x.dtype)
        y_a = (o_a * jax.nn.silu(dsa_z)) @ w_up_a[layer]

        cqkv = jax.nn.silu(_causal_depthwise_conv(gdn_qkv, conv_w[layer])).astype(f32)
        gq, gk, gv = jnp.split(cqkv, [GDN_K_WIDTH, 2 * GDN_K_WIDTH], axis=-1)
        gq = _l2norm(gq.reshape(b, s, GDN_HEADS, GDN_KEY_DIM)) * GDN_KEY_DIM ** -0.5
        gk = _l2norm(gk.reshape(b, s, GDN_HEADS, GDN_KEY_DIM))
        gv = gv.reshape(b, s, GDN_HEADS, GDN_VAL_DIM)
        beta = jax.nn.sigmoid(gdn_b.astype(f32))
        g = -jnp.exp(a_log[layer].astype(f32)) * jax.nn.softplus(gdn_a.astype(f32) + dt_bias[layer].astype(f32))
        o_b = _gated_delta_rule(gq, gk, gv, g, beta)
        o_b = _rmsnorm(o_b, gdn_norm_w[layer]).reshape(b, s, GDN_V_WIDTH).astype(x.dtype)
        y_b = (o_b * jax.nn.silu(gdn_z)) @ w_up_b[layer]

        merged = jax.nn.sigmoid(gate_a) * y_a + jax.nn.sigmoid(gate_b) * y_b
        x = x + merged @ w_out[layer]
    return _rmsnorm(x, final_norm_w)
```

```cpp
#include <hip/hip_runtime.h>
#include <hip/hip_cooperative_groups.h>
#include <stdint.h>
#include <stdio.h>
namespace cg = cooperative_groups;

typedef __attribute__((ext_vector_type(8))) short bf16x8;
typedef __attribute__((ext_vector_type(4))) float f32x4;
typedef unsigned short u16;

#define DEVFN __device__ __forceinline__

constexpr int SEQ = 8192, NWIN = 9232;
constexpr float EPS = 1e-6f;
constexpr int NT = 256;
constexpr int SMEM_BYTES = 73728;

#define DEVFN_ __device__ __forceinline__
struct Params {
  const float *x, *norm_w, *w_in, *conv_w, *a_log, *dt_bias, *gdn_norm_w, *w_up_a, *w_up_b, *w_out, *final_norm_w;
  float* out;
  char* ws;
  DEVFN_ u16* Qp() const { return (u16*)(ws); }
  DEVFN_ u16* Kp() const { return (u16*)(ws + 50331648ull); }
  DEVFN_ u16* Vt() const { return (u16*)(ws + 100663296ull); }
  DEVFN_ u16* Pg() const { return (u16*)(ws + 150994944ull); }
  DEVFN_ u16* WtIn() const { return (u16*)(ws + 201326592ull); }
  DEVFN_ u16* WtUpA() const { return (u16*)(ws + 220200960ull); }
  DEVFN_ u16* WtUpB() const { return (u16*)(ws + 221249536ull); }
  DEVFN_ u16* WtOut() const { return (u16*)(ws + 222298112ull); }
  DEVFN_ float* ropeC() const { return (float*)(ws + 224395264ull); }
  DEVFN_ float* ropeS() const { return (float*)(ws + 225443840ull); }
  DEVFN_ float* bg() const { return (float*)(ws + 226492416ull); }
  DEVFN_ float* lse() const { return (float*)(ws + 227540992ull); }
  DEVFN_ float* rowss() const { return (float*)(ws + 229113856ull); }
  DEVFN_ u16* Sbuf() const { return (u16*)(ws + 229179392ull); }
  DEVFN_ u16* chunk() const { return Kp(); }
  DEVFN_ u16* merged() const { return Qp(); }
};

DEVFN int get_tid() { int t = threadIdx.x; asm volatile("" : "+v"(t)); return t; }
typedef __attribute__((ext_vector_type(2))) __bf16 bf16x2_t;
typedef __attribute__((ext_vector_type(2))) float f32x2_t;
DEVFN unsigned pack2(float a, float b) {
  f32x2_t v = {a, b};
  bf16x2_t r = __builtin_convertvector(v, bf16x2_t);
  return __builtin_bit_cast(unsigned, r);
}
DEVFN u16 f2bf(float f) { return (u16)(pack2(f, 0.f) & 0xffffu); }
DEVFN float bf2f(u16 h) { return __uint_as_float(((unsigned)h) << 16); }
DEVFN float sigm(float x) { return __builtin_amdgcn_rcpf(1.f + __expf(-x)); }
DEVFN float silu(float x) { return x * __builtin_amdgcn_rcpf(1.f + __expf(-x)); }
DEVFN void stage4(u16* trow, float v0, float v1, float v2, float v3) {
  const unsigned p01 = pack2(v0, v1), p23 = pack2(v2, v3);
  trow[0] = (u16)(p01 & 0xffffu); trow[16] = (u16)(p01 >> 16);
  trow[32] = (u16)(p23 & 0xffffu); trow[48] = (u16)(p23 >> 16);
}

DEVFN int permk(int j) { return (j & 32) | ((j & 12) << 1) | ((j & 16) >> 2) | (j & 3); }

union BF8 { bf16x8 v; unsigned u[4]; uint4 q; };

DEVFN bf16x8 pack8(const f32x4& a, const f32x4& b) {
  BF8 r;
  r.u[0] = pack2(a[0], a[1]); r.u[1] = pack2(a[2], a[3]);
  r.u[2] = pack2(b[0], b[1]); r.u[3] = pack2(b[2], b[3]);
  return r.v;
}

#define MFMA16(a, b, c) __builtin_amdgcn_mfma_f32_16x16x32_bf16((a), (b), (c), 0, 0, 0)
#define MFMAF32(a, b, c) __builtin_amdgcn_mfma_f32_16x16x4f32((a), (b), (c), 0, 0, 0)

#define XB_TMO      128
#define XB_XCNT(j)  (256  + 64 * (j))
#define XB_XSUB(j)  (1280 + 64 * (j))
#define XB_XGEN(j)  (2304 + 64 * (j))
#define XB_TOP      3328
#define XB_TOPGEN   3392
#define XCD_BAR_WORDS 3456
#define XB_SPIN_CAP (1u << 18)
#define LAS __attribute__((address_space(3)))

__device__ __forceinline__ unsigned xb_ld(unsigned* p)              { return __hip_atomic_load(p, __ATOMIC_RELAXED, __HIP_MEMORY_SCOPE_AGENT); }
__device__ __forceinline__ unsigned xb_add(unsigned* p, unsigned v) { return __hip_atomic_fetch_add(p, v, __ATOMIC_RELAXED, __HIP_MEMORY_SCOPE_AGENT); }
__device__ __forceinline__ unsigned xb_xcc_id() { return (unsigned)__builtin_amdgcn_s_getreg((3 << 11) | 20) & 0xFu; }
#define XB_SPIN(cond, bar) do { unsigned _sp = 0; while (cond) { __builtin_amdgcn_s_sleep(1); \
    if ((++_sp & 255u) == 0u) { if (xb_ld(&(bar)[XB_TMO])) break; if (_sp > XB_SPIN_CAP) { atomicAdd(&(bar)[XB_TMO], 1u); break; } } } } while (0)

struct XcdBarrier {
    unsigned* bar; unsigned x;
    volatile LAS unsigned* st;
};

__device__ __forceinline__ XcdBarrier xcd_barrier_post(unsigned* bar, volatile LAS unsigned* st) {
    XcdBarrier b; b.bar = bar; b.x = xb_xcc_id(); b.st = st;
    if (threadIdx.x == 0) (void)xb_add(&bar[XB_XCNT(b.x)], 1u);
    return b;
}
__device__ __forceinline__ void xcd_barrier_complete(unsigned* bar, unsigned x, unsigned& nloc, unsigned& nx) {
    const unsigned G = gridDim.x * gridDim.y * gridDim.z;
    unsigned sum, cnt, mine, sp = 0u;
    for (;;) {
        sum = 0u; cnt = 0u; mine = 0u;
#pragma unroll
        for (unsigned j = 0; j < 16; ++j) { const unsigned c = xb_ld(&bar[XB_XCNT(j)]); sum += c; cnt += (c > 0u) ? 1u : 0u; mine = (j == x) ? c : mine; }
        if (sum == G) break;
        __builtin_amdgcn_s_sleep(1);
        if ((++sp & 255u) == 0u) { if (xb_ld(&bar[XB_TMO])) break; if (sp > XB_SPIN_CAP) { atomicAdd(&bar[XB_TMO], 1u); break; } }
    }
    nloc = mine > 0u ? mine : 1u; nx = cnt > 0u ? cnt : 1u;
}

__device__ __forceinline__ void xcd_barrier(const XcdBarrier& b) {
    asm volatile("s_waitcnt vmcnt(0)" ::: "memory");
    __syncthreads();
    if (threadIdx.x == 0) {
        unsigned* bar = b.bar;
        __builtin_amdgcn_s_waitcnt(0);
        unsigned nloc = b.st[0], nx = b.st[1];
        if (nloc == 0u) { xcd_barrier_complete(bar, b.x, nloc, nx); b.st[0] = nloc; b.st[1] = nx; }
        const unsigned old = xb_add(&bar[XB_XSUB(b.x)], 1u);
        const unsigned gen = old / nloc;
        if (old + 1u == (gen + 1u) * nloc) {
            __builtin_amdgcn_fence(__ATOMIC_RELEASE, "agent");
            asm volatile("s_waitcnt vmcnt(0)" ::: "memory");
            const unsigned og = xb_add(&bar[XB_TOP], 1u);
            const unsigned tg = og / nx;
            if (og + 1u == (tg + 1u) * nx) xb_add(&bar[XB_TOPGEN], 1u);
            else XB_SPIN(xb_ld(&bar[XB_TOPGEN]) == tg, bar);
            __builtin_amdgcn_fence(__ATOMIC_ACQUIRE, "agent");
            xb_add(&bar[XB_XGEN(b.x)], 1u);
            asm volatile("s_waitcnt vmcnt(0)" ::: "memory");
        } else {
            XB_SPIN(xb_ld(&bar[XB_XGEN(b.x)]) == gen, bar);
            __builtin_amdgcn_fence(__ATOMIC_ACQUIRE, "agent");
            asm volatile("s_waitcnt vmcnt(0)" ::: "memory");
        }
    }
    __syncthreads();
}


DEVFN void gemm_core(const u16* __restrict__ A, int lda, const u16* __restrict__ B, int ldb, int K,
                     u16* sm, f32x4 (&acc)[8][4]) {
  const int tid = get_tid(), lane = tid & 63, wave = tid >> 6, wr = wave >> 1, wc = wave & 1;
  const int lrow = tid >> 2, lc = tid & 3;
  const int wofs = lrow * 32 + ((lc ^ ((4 - ((lrow >> 2) & 3)) & 3)) << 3);
  const int l15 = lane & 15, kq = lane >> 4;
  const int co = ((kq ^ ((4 - (l15 >> 2)) & 3)) << 3);
  uint4 ra0_0, ra0_1, ra0_2, ra0_3, rb0_0, rb0_1, ra1_0, ra1_1, ra1_2, ra1_3, rb1_0, rb1_1;
  const u16* Ap = A + (size_t)lrow * lda + lc * 8;
  const u16* Bp = B + (size_t)lrow * ldb + lc * 8;
#define G_LOADA(RA, k0, i) RA##_##i = *(const uint4*)(Ap + (size_t)(64 * i) * lda + (k0));
#define G_LOADB(RB, k0, i) RB##_##i = *(const uint4*)(Bp + (size_t)(64 * i) * ldb + (k0));
#define G_LOAD(RA, RB, k0) G_LOADA(RA, k0, 0) G_LOADA(RA, k0, 1) G_LOADA(RA, k0, 2) G_LOADA(RA, k0, 3) G_LOADB(RB, k0, 0) G_LOADB(RB, k0, 1)
#define G_STOREA(RA, buf, i) *(uint4*)(sm + (buf) * 12288 + 64 * i * 32 + wofs) = RA##_##i;
#define G_STOREB(RB, buf, i) *(uint4*)(sm + (buf) * 12288 + 8192 + 64 * i * 32 + wofs) = RB##_##i;
#define G_STORE(RA, RB, buf) G_STOREA(RA, buf, 0) G_STOREA(RA, buf, 1) G_STOREA(RA, buf, 2) G_STOREA(RA, buf, 3) G_STOREB(RB, buf, 0) G_STOREB(RB, buf, 1)
#define G_COMPUTE(buf)                                                                         \
  {                                                                                            \
    const u16* as = sm + (buf) * 12288 + (wr * 128 + l15) * 32 + co;                           \
    const u16* bs = sm + (buf) * 12288 + 8192 + (wc * 64 + l15) * 32 + co;                     \
    bf16x8 b[4];                                                                               \
    _Pragma("unroll") for (int nt = 0; nt < 4; ++nt) b[nt] = *(const bf16x8*)(bs + nt * 512); \
    bf16x8 a[8];                                                                               \
    _Pragma("unroll") for (int mt = 0; mt < 8; ++mt) a[mt] = *(const bf16x8*)(as + mt * 512);  \
    __builtin_amdgcn_s_setprio(1);                                                             \
    _Pragma("unroll") for (int mt = 0; mt < 8; ++mt) {                                         \
      _Pragma("unroll") for (int nt = 0; nt < 4; ++nt) acc[mt][nt] = MFMA16(a[mt], b[nt], acc[mt][nt]); \
    }                                                                                          \
    __builtin_amdgcn_s_setprio(0);                                                             \
  }
  const int nk = K >> 5;
  G_LOAD(ra0, rb0, 0)
  G_LOAD(ra1, rb1, 32)
  G_STORE(ra0, rb0, 0)
  __syncthreads();
#pragma unroll 1
  for (int kt = 0; kt < nk; kt += 2) {
    const int k2 = (kt + 2 < nk ? kt + 2 : nk - 1) * 32, k3 = (kt + 3 < nk ? kt + 3 : nk - 1) * 32;
    G_LOAD(ra0, rb0, k2)
    G_COMPUTE(0)
    G_STORE(ra1, rb1, 1)
    __syncthreads();
    G_LOAD(ra1, rb1, k3)
    G_COMPUTE(1)
    G_STORE(ra0, rb0, 0)
    __syncthreads();
  }
#undef G_LOAD
#undef G_STORE
#undef G_LOADA
#undef G_LOADB
#undef G_STOREA
#undef G_STOREB
#undef G_COMPUTE
}

DEVFN void zero_acc(f32x4 (&acc)[8][4]) {
#pragma unroll
  for (int i = 0; i < 8; ++i)
#pragma unroll
    for (int j = 0; j < 4; ++j) acc[i][j] = f32x4{0.f, 0.f, 0.f, 0.f};
}

DEVFN void transpose_tile(const float* __restrict__ src, int ld, int K, u16* __restrict__ dst, int k0, int n0, int nsrc, float* ts) {
  const int tid = get_tid();
#pragma unroll
  for (int i = 0; i < 4; ++i) {
    const int idx = tid + NT * i, kk = idx >> 4, n4 = (idx & 15) * 4;
    const float4 v = *(const float4*)(src + (size_t)(k0 + kk) * ld + nsrc + n4);
    ts[kk * 65 + n4 + 0] = v.x; ts[kk * 65 + n4 + 1] = v.y; ts[kk * 65 + n4 + 2] = v.z; ts[kk * 65 + n4 + 3] = v.w;
  }
  __syncthreads();
#pragma unroll
  for (int i = 0; i < 4; ++i) {
    const int idx = tid + NT * i, nn = idx >> 4, k4 = (idx & 15) * 4;
    uint2 pk;
    pk.x = pack2(ts[(k4 + 0) * 65 + nn], ts[(k4 + 1) * 65 + nn]);
    pk.y = pack2(ts[(k4 + 2) * 65 + nn], ts[(k4 + 3) * 65 + nn]);
    *(uint2*)(dst + (size_t)(n0 + nn) * K + k0 + k4) = pk;
  }
  __syncthreads();
}

DEVFN void phase0(const Params& p, char* smem) {
  const int tid = get_tid(), lane = tid & 63, wave = tid >> 6;
  const int bid = blockIdx.x, nb = gridDim.x;
  float* ts = (float*)smem;
  for (int t = bid; t < 1792; t += nb) {
    const int n0 = (t >> 4) * 64, k0 = (t & 15) * 64;
    transpose_tile(p.w_in, NWIN, 1024, p.WtIn(), k0, n0, n0, ts);
  }
  for (int idx = bid * NT + tid; idx < SEQ * 32; idx += nb * NT) {
    int pos = idx >> 5, i = idx & 31;
    float inv = powf(10000.f, -(float)i / 32.f);
    float ang = (float)pos * inv;
    double a = (double)ang;
    double n = rint(a * 0.15915494309189535);
    float r = (float)(a - n * 6.283185307179586);
    p.ropeC()[idx] = cosf(r);
    p.ropeS()[idx] = sinf(r);
    if (idx < 16384) p.rowss()[idx] = 0.f;
  }
  float* wt = (float*)smem;
  for (int idx = tid; idx < 4096; idx += NT) {
    const int k = idx & 1023, j4 = idx >> 10;
    const float4 w4 = *(const float4*)(p.w_in + (size_t)k * NWIN + 7168 + 4 * j4);
    wt[(4 * j4 + 0) * 1024 + k] = w4.x; wt[(4 * j4 + 1) * 1024 + k] = w4.y;
    wt[(4 * j4 + 2) * 1024 + k] = w4.z; wt[(4 * j4 + 3) * 1024 + k] = w4.w;
  }
  __syncthreads();
  float4 nw[4];
#pragma unroll
  for (int i4 = 0; i4 < 4; ++i4) nw[i4] = ((const float4*)p.norm_w)[lane + 64 * i4];
  u16* h16 = (u16*)p.out;
  for (int grp = bid * 4 + wave; grp < 4096; grp += nb * 4) {
    float4 hv[4][4];
#pragma unroll
    for (int r = 0; r < 4; ++r) {
      const int row = grp * 4 + r;
      const float4* xr = (const float4*)(p.x + (size_t)row * 1024);
      float ss = 0.f;
#pragma unroll
      for (int i4 = 0; i4 < 4; ++i4) {
        float4 v = xr[lane + 64 * i4];
        hv[r][i4] = v;
        ss += v.x * v.x + v.y * v.y + v.z * v.z + v.w * v.w;
      }
#pragma unroll
      for (int o = 32; o >= 1; o >>= 1) ss += __shfl_xor(ss, o);
      const float rs = rsqrtf(ss * (1.f / 1024.f) + EPS);
#pragma unroll
      for (int i4 = 0; i4 < 4; ++i4) {
        float4 v = hv[r][i4];
        v.x *= rs * nw[i4].x; v.y *= rs * nw[i4].y; v.z *= rs * nw[i4].z; v.w *= rs * nw[i4].w;
        hv[r][i4] = v;
        uint2 pk; pk.x = pack2(v.x, v.y); pk.y = pack2(v.z, v.w);
        *(uint2*)(h16 + (size_t)row * 1024 + 4 * (lane + 64 * i4)) = pk;
      }
    }
    float myval = 0.f;
    const bool up5 = (lane & 32) != 0, up4 = (lane & 16) != 0, up1 = (lane & 2) != 0, up0 = (lane & 1) != 0;
#pragma unroll 1
    for (int jj = 0; jj < 4; ++jj) {
      float a[4][4];
#pragma unroll
      for (int r = 0; r < 4; ++r)
#pragma unroll
        for (int q = 0; q < 4; ++q) a[r][q] = 0.f;
#pragma unroll
      for (int q = 0; q < 4; ++q)
#pragma unroll
        for (int i4 = 0; i4 < 4; ++i4) {
          const float4 w4 = ((const float4*)(wt + (4 * jj + q) * 1024))[lane + 64 * i4];
#pragma unroll
          for (int r = 0; r < 4; ++r)
            a[r][q] += hv[r][i4].x * w4.x + hv[r][i4].y * w4.y + hv[r][i4].z * w4.z + hv[r][i4].w * w4.w;
        }
      float b[2][4], c[4], d[2];
#pragma unroll
      for (int rr = 0; rr < 2; ++rr)
#pragma unroll
        for (int q = 0; q < 4; ++q) {
          const float send = up5 ? a[rr][q] : a[rr + 2][q], keep = up5 ? a[rr + 2][q] : a[rr][q];
          b[rr][q] = keep + __shfl_xor(send, 32);
        }
#pragma unroll
      for (int q = 0; q < 4; ++q) {
        const float send = up4 ? b[0][q] : b[1][q], keep = up4 ? b[1][q] : b[0][q];
        c[q] = keep + __shfl_xor(send, 16);
      }
#pragma unroll
      for (int qq = 0; qq < 2; ++qq) {
        const float send = up1 ? c[qq] : c[qq + 2], keep = up1 ? c[qq + 2] : c[qq];
        d[qq] = keep + __shfl_xor(send, 2);
      }
      float e;
      {
        const float send = up0 ? d[0] : d[1], keep = up0 ? d[1] : d[0];
        e = keep + __shfl_xor(send, 1);
      }
      e += __shfl_xor(e, 8);
      e += __shfl_xor(e, 4);
      if (((lane >> 2) & 3) == jj) myval = e;
    }
    {
      const int r = lane >> 4, j = lane & 15;
      const int row = grp * 4 + r;
      float val = myval, res;
      if (j < 8) res = sigm(val);
      else {
        const int hh = j - 8;
        const float z = val + p.dt_bias[hh];
        const float sp = fmaxf(z, 0.f) + log1pf(__expf(-fabsf(z)));
        res = -__expf(p.a_log[hh]) * sp;
      }
      p.bg()[(size_t)row * 16 + j] = res;
    }
  }
  __syncthreads();
}

DEVFN void phase1(const Params& p, char* smem) {
  u16* out16 = (u16*)p.out;
  u16* T = (u16*)smem;
  for (int t = blockIdx.x; t < 64 * 56; t += gridDim.x) {
    const int tid = get_tid(), lane = tid & 63, wave = tid >> 6, wr = wave >> 1, wc = wave & 1;
    const int kq = lane >> 4, l15 = lane & 15;
    int mt_ = t & 63, nt_ = t >> 6;
    if (gridDim.x == 512) {
      const int xcd = blockIdx.x & 7, j = blockIdx.x >> 3, i = t >> 9;
      mt_ = xcd * 8 + (j & 7);
      nt_ = i * 8 + (j >> 3);
    }
    const int row0 = mt_ * 256;
    f32x4 acc[8][4];
    zero_acc(acc);
    gemm_core(out16 + (size_t)row0 * 1024, 1024, p.WtIn() + (size_t)(nt_ * 128) * 1024, 1024, 1024, (u16*)smem, acc);
    const int bq = row0 >> 13;
    const int s0 = row0 & 8191;
    if (nt_ < 36) {
      const int g = nt_ / 12, tt = (nt_ % 12) >> 2;
      const int sh = 2 * g;
      if (tt < 2) {
        const float sc = (tt == 0) ? 0.18033688011112042f : 1.f;
#pragma unroll
        for (int mt = 0; mt < 8; ++mt)
#pragma unroll
          for (int r = 0; r < 4; ++r) {
            const int lrow = wr * 128 + mt * 16 + kq * 4 + r;
            const int s = s0 + lrow;
#pragma unroll
            for (int nt = 0; nt < 2; ++nt) {
              const int d = nt * 16 + l15;
              const float c = p.ropeC()[s * 32 + d], sn = p.ropeS()[s * 32 + d];
              const float lo = acc[mt][nt][r], hi = acc[mt][nt + 2][r];
              const unsigned pk = pack2((lo * c - hi * sn) * sc, (hi * c + lo * sn) * sc);
              T[lrow * 136 + wc * 64 + d] = (u16)(pk & 0xffffu);
              T[lrow * 136 + wc * 64 + d + 32] = (u16)(pk >> 16);
            }
          }
        __syncthreads();
        u16* dstb = (tt == 0 ? p.Qp() : p.Kp());
#pragma unroll
        for (int i = 0; i < 16; ++i) {
          const int id = tid + 256 * i, lrow = id >> 4, pc = id & 15;
          const uint4 v = *(const uint4*)(T + lrow * 136 + pc * 8);
          const int s = s0 + lrow;
          const int pos = ((s & ((1 << sh) - 1)) << (13 - sh)) + (s >> sh);
          const int head = ((nt_ & 3) << 1) + (pc >> 3);
          const size_t hb = (size_t)((bq * 3 + g) * 8 + head);
          *(uint4*)(dstb + (hb * 8192 + pos) * 64 + (pc & 7) * 8) = v;
        }
      } else {
#pragma unroll
        for (int mt = 0; mt < 8; ++mt)
#pragma unroll
          for (int r = 0; r < 4; ++r) {
            const int lrow = wr * 128 + mt * 16 + kq * 4 + r;
            const int rho = ((lrow & ((1 << sh) - 1)) << (8 - sh)) + (lrow >> sh);
#pragma unroll
            for (int nt = 0; nt < 4; nt += 2) {
              const unsigned pk = pack2(acc[mt][nt][r], acc[mt][nt + 1][r]);
              T[(wc * 64 + nt * 16 + l15) * 264 + rho] = (u16)(pk & 0xffffu);
              T[(wc * 64 + (nt + 1) * 16 + l15) * 264 + rho] = (u16)(pk >> 16);
            }
          }
        __syncthreads();
#pragma unroll
        for (int i = 0; i < 16; ++i) {
          const int id = tid + 256 * i, col = id >> 5, q = id & 31;
          const uint4 v = *(const uint4*)(T + col * 264 + q * 8);
          const int rho0 = q * 8;
          const int r_ = rho0 >> (8 - sh), j0 = rho0 & ((256 >> sh) - 1);
          const int pos = (r_ << (13 - sh)) + (s0 >> sh) + j0;
          const int head = ((nt_ & 3) << 1) + (col >> 6), d = col & 63;
          const size_t hb = (size_t)((bq * 3 + g) * 8 + head);
          *(uint4*)(p.Vt() + (hb * 64 + d) * 8192 + pos) = v;
        }
      }
    } else {
      u16* dst; int ldd; bool act;
      if (nt_ < 40) { dst = out16 + 16777216 + (nt_ - 36) * 128; ldd = 1024; act = true; }
      else if (nt_ < 52) { dst = p.Pg() + (nt_ - 40) * 128; ldd = 1536; act = false; }
      else { dst = out16 + 16777216 + 512 + (nt_ - 52) * 128; ldd = 1024; act = true; }
#pragma unroll
      for (int mt = 0; mt < 8; ++mt)
#pragma unroll
        for (int r = 0; r < 4; ++r) {
          const int lrow = wr * 128 + mt * 16 + kq * 4 + r;
          float v4[4];
#pragma unroll
          for (int nt = 0; nt < 4; ++nt) { float v = acc[mt][nt][r]; if (act) v = silu(v); v4[nt] = v; }
          stage4(T + lrow * 136 + wc * 64 + l15, v4[0], v4[1], v4[2], v4[3]);
        }
      __syncthreads();
#pragma unroll
      for (int i = 0; i < 16; ++i) {
        const int id = tid + 256 * i, lrow = id >> 4, pc = id & 15;
        const uint4 v = *(const uint4*)(T + lrow * 136 + pc * 8);
        *(uint4*)(dst + (size_t)(row0 + lrow) * ldd + pc * 8) = v;
      }
    }
    __syncthreads();
  }
}

DEVFN void phase_attn(const Params& p, char* smem) {
  const int tid = get_tid(), lane = tid & 63, wave = tid >> 6;
  const int kq = lane >> 4, l15 = lane & 15;
  u16* Ks = (u16*)smem;
  u16* Vs = Ks + 256 * 72;
  uint4 kr_0, kr_1, kr_2, kr_3, kr_4, kr_5, kr_6, kr_7, vr_0, vr_1, vr_2, vr_3, vr_4, vr_5, vr_6, vr_7;
  bf16x8 qn_00, qn_01, qn_10, qn_11;
#define ATT_LDK(i) kr_##i = *(const uint4*)(kp_ + 32 * i * 64);
#define ATT_LDV(i) vr_##i = *(const uint4*)(vp_ + (long)(8 * i) * 8192);
#define ATT_LOADKQ(it)                                                                                 \
  {                                                                                                     \
    const int kb_ = (it) & 63, base_ = (it) >> 6, p0_ = kb_ * 128;                                      \
    const u16* kp_ = p.Kp() + (((long)base_ * 8192 + p0_ - 128) * 64 + (tid >> 3) * 64 + (tid & 7) * 8); \
    ATT_LDK(0) ATT_LDK(1) ATT_LDK(2) ATT_LDK(3) ATT_LDK(4) ATT_LDK(5) ATT_LDK(6) ATT_LDK(7)             \
    const u16* Qn_ = p.Qp() + ((size_t)base_ * 8192 + p0_ + 32 * wave) * 64 + l15 * 64 + kq * 8;        \
    qn_00 = *(const bf16x8*)(Qn_); qn_01 = *(const bf16x8*)(Qn_ + 32);                                  \
    qn_10 = *(const bf16x8*)(Qn_ + 1024); qn_11 = *(const bf16x8*)(Qn_ + 1024 + 32);                    \
  }
#define ATT_LOADV(it)                                                                                  \
  {                                                                                                     \
    const int kb_ = (it) & 63, base_ = (it) >> 6, p0_ = kb_ * 128;                                      \
    const u16* vp_ = p.Vt() + ((long)base_ * 64 * 8192 + p0_ - 128 + (long)(tid >> 5) * 8192 + (tid & 31) * 8); \
    ATT_LDV(0) ATT_LDV(1) ATT_LDV(2) ATT_LDV(3) ATT_LDV(4) ATT_LDV(5) ATT_LDV(6) ATT_LDV(7)             \
  }
#define ATT_STK(i) *(uint4*)(Ks + ((tid >> 3) + 32 * i) * 72 + (tid & 7) * 8) = kr_##i;
#define ATT_STV(i) *(uint4*)(Vs + ((tid >> 5) + 8 * i) * 264 + (tid & 31) * 8) = vr_##i;
  ATT_LOADKQ(blockIdx.x < 3072 ? (int)blockIdx.x : 0)
  for (int item = blockIdx.x; item < 3072; item += gridDim.x) {
    const int kb = item & 63, base = item >> 6;
    const int h = base & 7, bg_ = base >> 3, g = bg_ % 3, b = bg_ / 3;
    const int sh = 2 * g, sublen = 8192 >> sh;
    const int p0 = kb * 128;
    const bool first = ((p0 & (sublen - 1)) == 0);
    ATT_STK(0) ATT_STK(1) ATT_STK(2) ATT_STK(3) ATT_STK(4) ATT_STK(5) ATT_STK(6) ATT_STK(7)
    bf16x8 qf[2][2];
    qf[0][0] = qn_00; qf[0][1] = qn_01; qf[1][0] = qn_10; qf[1][1] = qn_11;
    __syncthreads();
    u16* Qg = p.Qp() + ((size_t)base * 8192 + p0 + 32 * wave) * 64;
    ATT_LOADV(item)
    {
      const int nxt = item + gridDim.x;
      const int itl = nxt < 3072 ? nxt : item;
      ATT_LOADKQ(itl)
    }
    __builtin_amdgcn_sched_barrier(0);
    f32x4 st[10][2];
#pragma unroll
    for (int mt = 0; mt < 10; ++mt) {
      const u16* kr = Ks + (32 * wave + mt * 16 + l15) * 72 + kq * 8;
      const bf16x8 k0 = *(const bf16x8*)kr, k1 = *(const bf16x8*)(kr + 32);
#pragma unroll
      for (int nt = 0; nt < 2; ++nt) {
        f32x4 c = f32x4{0.f, 0.f, 0.f, 0.f};
        if (mt - nt >= 0 && mt - nt <= 8) {
          c = MFMA16(k0, qf[nt][0], c);
          c = MFMA16(k1, qf[nt][1], c);
        }
        st[mt][nt] = c;
      }
    }
    float mx[2] = {-1e30f, -1e30f};
#pragma unroll
    for (int mt = 0; mt < 10; ++mt)
#pragma unroll
      for (int nt = 0; nt < 2; ++nt) {
        const int dd = mt - nt;
#pragma unroll
        for (int r = 0; r < 4; ++r) {
          float s = st[mt][nt][r];
          if (dd < 0 || dd > 8) s = -1e30f;
          else if (dd == 0) { if (kq * 4 + r - l15 < 0) s = -1e30f; }
          else if (dd == 8) { if (kq * 4 + r - l15 > 0) s = -1e30f; }
          st[mt][nt][r] = s;
        }
      }
    if (first) {
#pragma unroll
      for (int mt = 0; mt < 10; ++mt)
#pragma unroll
        for (int nt = 0; nt < 2; ++nt)
#pragma unroll
          for (int r = 0; r < 4; ++r)
            if (32 * wave + mt * 16 + kq * 4 + r < 128) st[mt][nt][r] = -1e30f;
    }
#pragma unroll
    for (int mt = 0; mt < 10; ++mt)
#pragma unroll
      for (int nt = 0; nt < 2; ++nt)
#pragma unroll
        for (int r = 0; r < 4; ++r) mx[nt] = fmaxf(mx[nt], st[mt][nt][r]);
    float sum[2] = {0.f, 0.f};
#pragma unroll
    for (int nt = 0; nt < 2; ++nt) {
      mx[nt] = fmaxf(mx[nt], __shfl_xor(mx[nt], 16));
      mx[nt] = fmaxf(mx[nt], __shfl_xor(mx[nt], 32));
    }
#pragma unroll
    for (int mt = 0; mt < 10; ++mt)
#pragma unroll
      for (int nt = 0; nt < 2; ++nt)
#pragma unroll
        for (int r = 0; r < 4; ++r) {
          const float e = __builtin_amdgcn_exp2f(st[mt][nt][r] - mx[nt]);
          st[mt][nt][r] = e;
          sum[nt] += e;
        }
#pragma unroll
    for (int nt = 0; nt < 2; ++nt) {
      sum[nt] += __shfl_xor(sum[nt], 16);
      sum[nt] += __shfl_xor(sum[nt], 32);
    }
    ATT_STV(0) ATT_STV(1) ATT_STV(2) ATT_STV(3) ATT_STV(4) ATT_STV(5) ATT_STV(6) ATT_STV(7)
    __syncthreads();
    f32x4 ot[4][2];
#pragma unroll
    for (int dt = 0; dt < 4; ++dt)
#pragma unroll
      for (int nt = 0; nt < 2; ++nt) ot[dt][nt] = f32x4{0.f, 0.f, 0.f, 0.f};
#pragma unroll
    for (int t = 0; t < 5; ++t) {
      bf16x8 pf[2];
#pragma unroll
      for (int nt = 0; nt < 2; ++nt) pf[nt] = pack8(st[2 * t][nt], st[2 * t + 1][nt]);
#pragma unroll
      for (int dt = 0; dt < 4; ++dt) {
        const u16* vr = Vs + (dt * 16 + l15) * 264 + 32 * wave + 32 * t + kq * 4;
        BF8 vf;
        const uint2 lo = *(const uint2*)vr, hi = *(const uint2*)(vr + 16);
        vf.u[0] = lo.x; vf.u[1] = lo.y; vf.u[2] = hi.x; vf.u[3] = hi.y;
#pragma unroll
        for (int nt = 0; nt < 2; ++nt) ot[dt][nt] = MFMA16(vf.v, pf[nt], ot[dt][nt]);
      }
    }
#pragma unroll
    for (int nt = 0; nt < 2; ++nt) {
      const float inv = 1.f / sum[nt];
#pragma unroll
      for (int dt = 0; dt < 4; ++dt) {
        uint2 pk;
        pk.x = pack2(ot[dt][nt][0] * inv, ot[dt][nt][1] * inv);
        pk.y = pack2(ot[dt][nt][2] * inv, ot[dt][nt][3] * inv);
        *(uint2*)(Qg + (nt * 16 + l15) * 64 + dt * 16 + kq * 4) = pk;
      }
      if (kq == 0) {
        const int pos = p0 + 32 * wave + nt * 16 + l15;
        const int r_ = pos >> (13 - sh), i_ = pos & (sublen - 1);
        const int s = (i_ << sh) + r_;
        p.lse()[((size_t)(b * 8192 + s)) * 24 + g * 8 + h] = (mx[nt] + log2f(sum[nt])) * 0.6931471805599453f;
      }
    }
  }
  __syncthreads();
}


DEVFN bf16x8 ld8_bf(const float* p) {
  const float4 a = *(const float4*)p, b = *(const float4*)(p + 4);
  BF8 r;
  r.u[0] = pack2(a.x, a.y); r.u[1] = pack2(a.z, a.w); r.u[2] = pack2(b.x, b.y); r.u[3] = pack2(b.z, b.w);
  return r.v;
}
DEVFN void ld8_bf_split(const float* p, bf16x8& hi, bf16x8& lo) {
  const float4 a = *(const float4*)p, b = *(const float4*)(p + 4);
  const float v[8] = {a.x, a.y, a.z, a.w, b.x, b.y, b.z, b.w};
  BF8 h, l;
#pragma unroll
  for (int e = 0; e < 4; ++e) {
    h.u[e] = pack2(v[2 * e], v[2 * e + 1]);
    const float r0 = v[2 * e] - __uint_as_float(h.u[e] << 16), r1 = v[2 * e + 1] - __uint_as_float(h.u[e] & 0xffff0000u);
    l.u[e] = pack2(r0, r1);
  }
  hi = h.v; lo = l.v;
}

template <int J, int I4> struct SolveInner {
  static DEVFN void run(float (&X)[64], const float* amT, float xj) {
    if (I4 + 3 > J) {
      const float4 a = *(const float4*)(amT + J * 68 + I4);
      if (I4 + 0 > J) X[I4 + 0] -= a.x * xj;
      if (I4 + 1 > J) X[I4 + 1] -= a.y * xj;
      if (I4 + 2 > J) X[I4 + 2] -= a.z * xj;
      if (I4 + 3 > J) X[I4 + 3] -= a.w * xj;
    }
    SolveInner<J, I4 + 4>::run(X, amT, xj);
  }
};
template <int J> struct SolveInner<J, 64> { static DEVFN void run(float (&)[64], const float*, float) {} };
template <int J> struct SolveOuter {
  static DEVFN void run(float (&X)[64], const float* amT) {
    SolveInner<J, ((J + 1) / 4) * 4>::run(X, amT, X[J]);
    if ((J & 3) == 3) __builtin_amdgcn_sched_barrier(0);
    SolveOuter<J + 1>::run(X, amT);
  }
};
template <> struct SolveOuter<63> { static DEVFN void run(float (&)[64], const float*) {} };

DEVFN void phase_chunk(const Params& p, char* smem) {
  float* qs = (float*)smem;
  float* ks = qs + 64 * 68;
  float* vs = ks + 64 * 68;
  float* amT = vs + 64 * 68;
  float* Gs = amT + 64 * 68;
  float* bs = Gs + 64;
  float* eG = bs + 64;
  float* eK = eG + 64;
  float* cwl = eK + 64;
  const bool one_bh = (gridDim.x == 512);
  if (one_bh) {
    const int h0 = blockIdx.x & 7;
    for (int idx = threadIdx.x; idx < 768; idx += NT) {
      const int sel = idx >> 8, j = (idx >> 6) & 3, d = idx & 63;
      cwl[idx] = p.conv_w[j * 1536 + sel * 512 + h0 * 64 + d];
    }
    __syncthreads();
  }
  for (int cit = blockIdx.x; cit < 2048; cit += gridDim.x) {
    int tid = threadIdx.x;
    asm volatile("" : "+v"(tid));
    const int lane = tid & 63, wave = __builtin_amdgcn_readfirstlane(tid >> 6);
    const int kq = lane >> 4, l15 = lane & 15;
    const int ci = one_bh ? ((int)(blockIdx.x & 15) * 128 + (int)(blockIdx.x >> 4) + 32 * (cit >> 9)) : cit;
    const int n = ci & 127, bh = ci >> 7, h = bh & 7, b = bh >> 3;
    const int row0 = b * 8192 + n * 64;
    u16* cb = p.chunk() + (size_t)ci * 24576;
    const float gg0 = p.bg()[(size_t)(row0 + lane) * 16 + 8 + h];
    const float be0 = p.bg()[(size_t)(row0 + lane) * 16 + h];
    {
      const int t = tid >> 2, part = tid & 3;
      BF8 raw[3][4][2];
      float msk[4];
#pragma unroll
      for (int j = 0; j < 4; ++j) {
        const int tok = n * 64 + t - 3 + j;
        msk[j] = tok >= 0 ? 1.f : 0.f;
        const int tokc = tok >= 0 ? tok : 0;
        const u16* src = p.Pg() + (size_t)(b * 8192 + tokc) * 1536 + h * 64 + part * 16;
#pragma unroll
        for (int sel = 0; sel < 3; ++sel) {
          raw[sel][j][0].q = *(const uint4*)(src + sel * 512);
          raw[sel][j][1].q = *(const uint4*)(src + sel * 512 + 8);
        }
      }
#pragma unroll
      for (int sel = 0; sel < 3; ++sel) {
        const int ch = sel * 512 + h * 64 + part * 16;
        float a[16];
#pragma unroll
        for (int d = 0; d < 16; ++d) a[d] = 0.f;
#pragma unroll
        for (int j = 0; j < 4; ++j) {
          const BF8& r0 = raw[sel][j][0];
          const BF8& r1 = raw[sel][j][1];
          const float* cwg = p.conv_w + j * 1536 + ch;
          const float* cws = cwl + (sel * 4 + j) * 64 + part * 16;
#pragma unroll
          for (int d = 0; d < 4; ++d) {
            float4 w4;
            if (one_bh) w4 = *(const float4*)(cws + 4 * d); else w4 = *(const float4*)(cwg + 4 * d);
            const float mj = msk[j];
            const unsigned ua = d < 2 ? r0.u[2 * d] : r1.u[2 * d - 4];
            const unsigned ub = d < 2 ? r0.u[2 * d + 1] : r1.u[2 * d - 3];
            a[4 * d + 0] += (w4.x * mj) * __uint_as_float(ua << 16);
            a[4 * d + 1] += (w4.y * mj) * __uint_as_float(ua & 0xffff0000u);
            a[4 * d + 2] += (w4.z * mj) * __uint_as_float(ub << 16);
            a[4 * d + 3] += (w4.w * mj) * __uint_as_float(ub & 0xffff0000u);
          }
        }
        float ss = 0.f;
#pragma unroll
        for (int d = 0; d < 16; ++d) { a[d] = silu(a[d]); ss += a[d] * a[d]; }
        float sc = 1.f;
        if (sel < 2) {
          ss += __shfl_xor(ss, 1);
          ss += __shfl_xor(ss, 2);
          sc = rsqrtf(ss + EPS) * (sel == 0 ? 0.125f : 1.f);
        }
        float* dst = (sel == 0 ? qs : (sel == 1 ? ks : vs)) + t * 68 + part * 16;
#pragma unroll
        for (int d = 0; d < 4; ++d) *(float4*)(dst + 4 * d) = make_float4(a[4 * d] * sc, a[4 * d + 1] * sc, a[4 * d + 2] * sc, a[4 * d + 3] * sc);
      }
    }
    if (wave == 0) {
      float gg = gg0;
#pragma unroll
      for (int o = 1; o < 64; o <<= 1) { const float v = __shfl_up(gg, o); if (lane >= o) gg += v; }
      const float gl = __shfl(gg, 63);
      Gs[lane] = gg;
      bs[lane] = be0;
      eG[lane] = __expf(gg);
      eK[lane] = __expf(gl - gg);
    }
    __syncthreads();
    {
      bf16x8 akh[2], akl[2], aqf[2];
#pragma unroll
      for (int t = 0; t < 2; ++t) {
        ld8_bf_split(ks + (16 * wave + l15) * 68 + 32 * t + kq * 8, akh[t], akl[t]);
        aqf[t] = ld8_bf(qs + (16 * wave + l15) * 68 + 32 * t + kq * 8);
      }
      u16* At = cb + 8192;
      for (int jt = 0; jt < 4; ++jt) {
        if (jt <= wave) {
          f32x4 cK = f32x4{0.f, 0.f, 0.f, 0.f}, cQ = f32x4{0.f, 0.f, 0.f, 0.f};
#pragma unroll
          for (int t = 0; t < 2; ++t) {
            bf16x8 bh, bl;
            ld8_bf_split(ks + (16 * jt + l15) * 68 + 32 * t + kq * 8, bh, bl);
            cK = MFMA16(akl[t], bh, cK);
            cK = MFMA16(akh[t], bl, cK);
            cK = MFMA16(akh[t], bh, cK);
            cQ = MFMA16(aqf[t], bh, cQ);
          }
          const int j = 16 * jt + l15;
          const float Gj = Gs[j];
          float av[4];
#pragma unroll
          for (int r = 0; r < 4; ++r) {
            const int i = 16 * wave + kq * 4 + r;
            const float e = (j <= i) ? __expf(Gs[i] - Gj) : 0.f;
            av[r] = (j < i) ? bs[i] * cK[r] * e : 0.f;
            At[i * 64 + permk(j)] = f2bf(cQ[r] * e);
          }
          *(float4*)(amT + j * 68 + 16 * wave + kq * 4) = make_float4(av[0], av[1], av[2], av[3]);
        } else {
          const int j = 16 * jt + l15;
#pragma unroll
          for (int r = 0; r < 4; ++r) At[(16 * wave + kq * 4 + r) * 64 + permk(j)] = 0;
        }
      }
    }
    __syncthreads();
    float X[64];
    if (tid < 64) {
#pragma unroll
      for (int i = 0; i < 64; ++i) X[i] = vs[i * 68 + tid] * bs[i];
    } else if (tid < 128) {
#pragma unroll
      for (int i = 0; i < 64; ++i) X[i] = ks[i * 68 + tid - 64] * bs[i] * eG[i];
    } else {
      const int tt = tid - 128;
      u16* Qd = cb + 4096;
      for (int idx = tt; idx < 4096; idx += 128) {
        const int c = idx >> 6, dk = idx & 63;
        Qd[c * 64 + permk(dk)] = f2bf(qs[c * 68 + dk] * eG[c]);
      }
    }
    __syncthreads();
    if (tid < 128) {
      SolveOuter<0>::run(X, amT);
      if (tid < 64) {
        const int v = tid;
        u16* U = cb + 12288;
#pragma unroll
        for (int i = 0; i < 64; ++i) {
          vs[i * 68 + v] = X[i];
          const int mt = i >> 4, kq2 = (i >> 2) & 3, r = i & 3;
          U[((v >> 4) * 64 + kq2 * 16 + (v & 15)) * 16 + mt * 4 + r] = f2bf(X[i]);
        }
      } else {
        const int dk = tid - 64;
        u16* W = cb;
        const int pk = permk(dk);
#pragma unroll
        for (int i = 0; i < 64; ++i) {
          qs[i * 68 + dk] = X[i];
          W[i * 64 + pk] = f2bf(X[i]);
        }
      }
    }
    __syncthreads();
    {
      const float dec = eG[63];
      bf16x8 akd[2];
#pragma unroll
      for (int t = 0; t < 2; ++t) {
        float v[8];
#pragma unroll
        for (int j = 0; j < 8; ++j) {
          const int c = 32 * t + kq * 8 + j;
          v[j] = ks[c * 68 + 16 * wave + l15] * eK[c];
        }
        BF8 r;
#pragma unroll
        for (int e = 0; e < 4; ++e) r.u[e] = pack2(v[2 * e], v[2 * e + 1]);
        akd[t] = r.v;
      }
      u16* Mo = cb + 16384;
      u16* Bo = cb + 20480;
#pragma unroll
      for (int jt = 0; jt < 4; ++jt) {
        f32x4 cM = f32x4{0.f, 0.f, 0.f, 0.f}, cB = f32x4{0.f, 0.f, 0.f, 0.f};
#pragma unroll
        for (int t = 0; t < 2; ++t) {
          BF8 bw, bu;
#pragma unroll
          for (int e = 0; e < 4; ++e) {
            const int c = 32 * t + kq * 8 + 2 * e;
            bw.u[e] = pack2(qs[c * 68 + 16 * jt + l15], qs[(c + 1) * 68 + 16 * jt + l15]);
            bu.u[e] = pack2(vs[c * 68 + 16 * jt + l15], vs[(c + 1) * 68 + 16 * jt + l15]);
          }
          cM = MFMA16(akd[t], bw.v, cM);
          cB = MFMA16(akd[t], bu.v, cB);
        }
        const int col = 16 * jt + l15;
        const int pc = permk(col);
#pragma unroll
        for (int r = 0; r < 4; ++r) {
          const int dkp = 16 * wave + kq * 4 + r;
          const float m = (dkp == col ? dec : 0.f) - cM[r];
          Mo[dkp * 64 + pc] = f2bf(m);
        }
        uint2 pk;
        pk.x = pack2(cB[0], cB[1]); pk.y = pack2(cB[2], cB[3]);
        *(uint2*)(Bo + (jt * 64 + lane) * 16 + wave * 4) = pk;
      }
    }
    __syncthreads();
  }
}

#define GREC_OFF 246415360ull
#define GHALF_OFF 250609664ull

#define SC_LOAD(st, rec, Moff, Boff)                                                        \
  {                                                                                          \
    const u16* cbn_ = (rec);                                                                 \
    _Pragma("unroll") for (int mt = 0; mt < 4; ++mt) {                                       \
      Mf[st][mt * 2 + 0] = *(const bf16x8*)(cbn_ + (Moff) + (mt * 16 + l15) * 64 + kq * 8);  \
      Mf[st][mt * 2 + 1] = *(const bf16x8*)(cbn_ + (Moff) + (mt * 16 + l15) * 64 + 32 + kq * 8); \
    }                                                                                        \
    Bq[st][0].q = *(const uint4*)(cbn_ + (Boff) + (vsl * 64 + lane) * 16);                   \
    Bq[st][1].q = *(const uint4*)(cbn_ + (Boff) + (vsl * 64 + lane) * 16 + 8);               \
  }

DEVFN f32x4 unpack_c(const BF8 (&Bq)[2], int mt) {
  const unsigned u0 = Bq[mt >> 1].u[(mt & 1) * 2], u1 = Bq[mt >> 1].u[(mt & 1) * 2 + 1];
  f32x4 c;
  c[0] = __uint_as_float(u0 << 16); c[1] = __uint_as_float(u0 & 0xffff0000u);
  c[2] = __uint_as_float(u1 << 16); c[3] = __uint_as_float(u1 & 0xffff0000u);
  return c;
}

template <int NS, bool STORE = true>
DEVFN void scan_steps(const u16* rec0, size_t rstride, int Moff, int Boff, bf16x8 (&Sb)[2], u16* sd0, size_t sstride,
                      int vsl, int lane) {
  const int kq = lane >> 4, l15 = lane & 15;
  bf16x8 Mf[4][8];
  BF8 Bq[4][2];
#pragma unroll
  for (int i = 0; i < 4 && i < NS; ++i) SC_LOAD(i, rec0 + (size_t)i * rstride, Moff, Boff)
#pragma unroll
  for (int i = 0; i < NS; ++i) {
    const int st = i & 3;
    f32x4 acc[4];
#pragma unroll
    for (int mt = 0; mt < 4; ++mt) {
      f32x4 c = unpack_c(Bq[st], mt);
      c = MFMA16(Mf[st][mt * 2 + 0], Sb[0], c);
      c = MFMA16(Mf[st][mt * 2 + 1], Sb[1], c);
      acc[mt] = c;
    }
    Sb[0] = pack8(acc[0], acc[1]);
    Sb[1] = pack8(acc[2], acc[3]);
    if (STORE) {
      u16* sd = sd0 + (size_t)i * sstride;
      *(bf16x8*)(sd) = Sb[0];
      *(bf16x8*)(sd + 512) = Sb[1];
    }
    if (i + 4 < NS) SC_LOAD(st, rec0 + (size_t)(i + 4) * rstride, Moff, Boff)
  }
}

typedef unsigned __attribute__((ext_vector_type(4))) u32x4s;
DEVFN void merge_tokens(const Params& p, int wid, int nw, int tk0, int tk1, int lane);
DEVFN void phase_scan_x1(const Params& p, char* smem) {
  const int tid = get_tid(), lane = tid & 63, wave = tid >> 6;
  if (gridDim.x == 512 && blockIdx.x >= 256) {
    merge_tokens(p, (blockIdx.x - 256) * 4 + wave, 1024, 0, 8192, lane);
    return;
  }
  const int kq = lane >> 4, l15 = lane & 15;
  const int vsl = wave;
  u16* grec = (u16*)(p.ws + GREC_OFF);
  for (int task = blockIdx.x; task < 256; task += gridDim.x) {
    const int bh = task >> 4, g = task & 15;
    const u16* rec0 = p.chunk() + (size_t)(bh * 128 + g * 8) * 24576;
    bf16x8 Mb[2], Bb[2];
    {
      BF8 m0, m1, z;
      z.q = make_uint4(0, 0, 0, 0);
      m0.q = z.q; m1.q = z.q;
      const int colr = vsl * 16 + l15;
#pragma unroll
      for (int j = 0; j < 8; ++j) {
        const int dk0 = (j >> 2) * 16 + kq * 4 + (j & 3);
        const unsigned one = 0x3f80u << ((j & 1) * 16);
        if (dk0 == colr) m0.u[j >> 1] |= one;
        if (dk0 + 32 == colr) m1.u[j >> 1] |= one;
      }
      Mb[0] = m0.v; Mb[1] = m1.v; Bb[0] = z.v; Bb[1] = z.v;
    }
    f32x4 aM[4], aB[4];
    u16* lbuf = (u16*)smem;
    const int row_w = tid >> 3, ch_w = tid & 7;
    const int woff = row_w * 64 + ((ch_w ^ ((row_w >> 1) & 7)) << 3);
    u32x4s rm[8][2];
    BF8 rb[8][2];
#pragma unroll
    for (int r = 0; r < 8; ++r) {
      const u16* rec_ = rec0 + (size_t)r * 24576;
      rm[r][0] = *(const u32x4s*)(rec_ + 16384 + tid * 8);
      rm[r][1] = *(const u32x4s*)(rec_ + 16384 + (tid + 256) * 8);
      rb[r][0].q = *(const uint4*)(rec_ + 20480 + (vsl * 64 + lane) * 16);
      rb[r][1].q = *(const uint4*)(rec_ + 20480 + (vsl * 64 + lane) * 16 + 8);
    }
#pragma unroll
    for (int i = 0; i < 8; ++i) {
      u16* lb = lbuf + (i & 1) * 4096;
      *(u32x4s*)(lb + woff) = rm[i][0];
      *(u32x4s*)(lb + woff + 32 * 64) = rm[i][1];
      __syncthreads();
#pragma unroll
      for (int mt = 0; mt < 4; ++mt) {
        const u16* fr = lb + (mt * 16 + l15) * 64;
        const bf16x8 m0 = *(const bf16x8*)(fr + (((0 + kq) ^ ((l15 >> 1) & 7)) << 3));
        const bf16x8 m1 = *(const bf16x8*)(fr + (((4 + kq) ^ ((l15 >> 1) & 7)) << 3));
        f32x4 c = f32x4{0.f, 0.f, 0.f, 0.f};
        c = MFMA16(m0, Mb[0], c);
        c = MFMA16(m1, Mb[1], c);
        aM[mt] = c;
        f32x4 d = unpack_c(rb[i], mt);
        d = MFMA16(m0, Bb[0], d);
        d = MFMA16(m1, Bb[1], d);
        aB[mt] = d;
      }
      Mb[0] = pack8(aM[0], aM[1]); Mb[1] = pack8(aM[2], aM[3]);
      Bb[0] = pack8(aB[0], aB[1]); Bb[1] = pack8(aB[2], aB[3]);
      if (i == 3) {
        u16* gh = (u16*)(p.ws + GHALF_OFF) + (size_t)task * 8192;
        const int pch = permk(vsl * 16 + l15);
#pragma unroll
        for (int mt = 0; mt < 4; ++mt) {
#pragma unroll
          for (int r = 0; r < 4; ++r) gh[(mt * 16 + kq * 4 + r) * 64 + pch] = f2bf(aM[mt][r]);
          uint2 pk;
          pk.x = pack2(aB[mt][0], aB[mt][1]); pk.y = pack2(aB[mt][2], aB[mt][3]);
          *(uint2*)(gh + 4096 + (vsl * 64 + lane) * 16 + mt * 4) = pk;
        }
      }
    }
    u16* gr = grec + (size_t)task * 8192;
    const int pc = permk(vsl * 16 + l15);
#pragma unroll
    for (int mt = 0; mt < 4; ++mt) {
#pragma unroll
      for (int r = 0; r < 4; ++r) gr[(mt * 16 + kq * 4 + r) * 64 + pc] = f2bf(aM[mt][r]);
      uint2 pk;
      pk.x = pack2(aB[mt][0], aB[mt][1]); pk.y = pack2(aB[mt][2], aB[mt][3]);
      *(uint2*)(gr + 4096 + (vsl * 64 + lane) * 16 + mt * 4) = pk;
    }
  }
}

DEVFN void merge_tokens(const Params& p, int wid, int nw, int tk0, int tk1, int lane) {
  u16* out16 = (u16*)p.out;
  for (int tk = tk0 + wid; tk < tk1; tk += nw) {
      const int b = tk >> 13, s = tk & 8191;
      const int hh = lane >> 3, d8 = (lane & 7) * 8;
      float l[3];
      BF8 og[3];
#pragma unroll
      for (int g = 0; g < 3; ++g) {
        const int sh = 2 * g;
        const int pos = ((s & ((1 << sh) - 1)) << (13 - sh)) + (s >> sh);
        og[g].q = *(const uint4*)(p.Qp() + ((size_t)((b * 3 + g) * 8 + hh) * 8192 + pos) * 64 + d8);
        l[g] = p.lse()[(size_t)tk * 24 + g * 8 + hh];
      }
      const float ml = fmaxf(l[0], fmaxf(l[1], l[2]));
      float w[3];
      float den = 0.f;
#pragma unroll
      for (int g = 0; g < 3; ++g) { w[g] = __expf(l[g] - ml); den += w[g]; }
      const float inv = 1.f / den;
      u16* zp = out16 + 16777216 + (size_t)tk * 1024 + hh * 64 + d8;
      BF8 z; z.q = *(const uint4*)zp;
      BF8 res;
#pragma unroll
      for (int i = 0; i < 4; ++i) {
        float o0 = 0.f, o1 = 0.f;
#pragma unroll
        for (int g = 0; g < 3; ++g) {
          o0 += w[g] * __uint_as_float(og[g].u[i] << 16);
          o1 += w[g] * __uint_as_float(og[g].u[i] & 0xffff0000u);
        }
        o0 *= inv * __uint_as_float(z.u[i] << 16);
        o1 *= inv * __uint_as_float(z.u[i] & 0xffff0000u);
        res.u[i] = pack2(o0, o1);
      }
      *(uint4*)zp = res.q;
    }
}

DEVFN void late_transposes(const Params& p, char* smem, int bm, int nbm) {
  float* ts = (float*)smem;
  for (int t = bm; t < 1024; t += nbm) {
    if (t < 512) {
      const int n0 = (112 + (t >> 4)) * 64, k0 = (t & 15) * 64;
      transpose_tile(p.w_in, NWIN, 1024, p.WtIn(), k0, n0, n0 + 16, ts);
    } else if (t < 640) {
      const int u = t - 512, n0 = (u >> 3) * 64, k0 = (u & 7) * 64;
      transpose_tile(p.w_up_a, 1024, 512, p.WtUpA(), k0, n0, n0, ts);
    } else if (t < 768) {
      const int u = t - 640, n0 = (u >> 3) * 64, k0 = (u & 7) * 64;
      transpose_tile(p.w_up_b, 1024, 512, p.WtUpB(), k0, n0, n0, ts);
    } else {
      const int u = t - 768, n0 = (u >> 4) * 64, k0 = (u & 15) * 64;
      transpose_tile(p.w_out, 1024, 1024, p.WtOut(), k0, n0, n0, ts);
    }
  }
}

DEVFN void phase_scan_merge(const Params& p, char* smem) {
  const int tid = get_tid(), lane = tid & 63, wave = tid >> 6;
  if (blockIdx.x < 16) {
    const int ci0 = blockIdx.x * 128;
    const int vsl = wave;
    bf16x8 Sb[2];
    {
      BF8 z; z.q = make_uint4(0, 0, 0, 0);
      Sb[0] = z.v; Sb[1] = z.v;
    }
    u16* sdst = p.Sbuf() + ((size_t)ci0 * 4 + vsl) * 1024 + lane * 8;
    *(bf16x8*)(sdst) = Sb[0];
    *(bf16x8*)(sdst + 512) = Sb[1];
    const u16* grec = (const u16*)(p.ws + GREC_OFF) + (size_t)blockIdx.x * 16 * 8192;
    {
      const int kq = lane >> 4, l15 = lane & 15;
      u16* lbuf = (u16*)smem;
      const int row_w = tid >> 3, ch_w = tid & 7;
      const int woff = row_w * 64 + ((ch_w ^ ((row_w >> 1) & 7)) << 3);
      u32x4s rm[8][2];
      BF8 rb[8][2];
#define X2_LOAD(slot, g)                                                                     \
      {                                                                                      \
        const u16* rec_ = grec + (size_t)(g) * 8192;                                         \
        rm[slot][0] = *(const u32x4s*)(rec_ + tid * 8);                                      \
        rm[slot][1] = *(const u32x4s*)(rec_ + (tid + 256) * 8);                              \
        rb[slot][0].q = *(const uint4*)(rec_ + 4096 + (vsl * 64 + lane) * 16);               \
        rb[slot][1].q = *(const uint4*)(rec_ + 4096 + (vsl * 64 + lane) * 16 + 8);           \
      }
#pragma unroll
      for (int r = 0; r < 8; ++r) X2_LOAD(r, r)
#pragma unroll
      for (int i = 0; i < 15; ++i) {
        const int sl = i & 7;
        u16* lb = lbuf + (i & 1) * 4096;
        *(u32x4s*)(lb + woff) = rm[sl][0];
        *(u32x4s*)(lb + woff + 32 * 64) = rm[sl][1];
        __syncthreads();
        const BF8 b0 = rb[sl][0], b1 = rb[sl][1];
        if (i + 8 < 15) X2_LOAD(sl, i + 8)
        f32x4 acc[4];
#pragma unroll
        for (int mt = 0; mt < 4; ++mt) {
          const u16* fr = lb + (mt * 16 + l15) * 64;
          const bf16x8 m0 = *(const bf16x8*)(fr + (((0 + kq) ^ ((l15 >> 1) & 7)) << 3));
          const bf16x8 m1 = *(const bf16x8*)(fr + (((4 + kq) ^ ((l15 >> 1) & 7)) << 3));
          const BF8& bb = (mt >> 1) ? b1 : b0;
          const unsigned u0 = bb.u[(mt & 1) * 2], u1 = bb.u[(mt & 1) * 2 + 1];
          f32x4 c;
          c[0] = __uint_as_float(u0 << 16); c[1] = __uint_as_float(u0 & 0xffff0000u);
          c[2] = __uint_as_float(u1 << 16); c[3] = __uint_as_float(u1 & 0xffff0000u);
          c = MFMA16(m0, Sb[0], c);
          c = MFMA16(m1, Sb[1], c);
          acc[mt] = c;
        }
        Sb[0] = pack8(acc[0], acc[1]);
        Sb[1] = pack8(acc[2], acc[3]);
        u16* sd = sdst + (size_t)(i + 1) * 8 * 4096;
        *(bf16x8*)(sd) = Sb[0];
        *(bf16x8*)(sd + 512) = Sb[1];
      }
#undef X2_LOAD
    }
  } else {
    late_transposes(p, smem, blockIdx.x - 16, gridDim.x - 16);
    if (gridDim.x == 512) merge_tokens(p, (blockIdx.x - 16) * 4 + wave, (gridDim.x - 16) * 4, 8192, 16384, lane);
    else merge_tokens(p, (blockIdx.x - 16) * 4 + wave, (gridDim.x - 16) * 4, 0, 16384, lane);
  }
}

DEVFN void phase_scan_x3(const Params& p) {
  const int tid = get_tid(), lane = tid & 63, wave = tid >> 6;
  const int vsl = wave;
  for (int task = blockIdx.x; task < 256; task += gridDim.x) {
    const int bh = task >> 4, g = task & 15;
    const int c0 = bh * 128 + g * 8;
    u16* sp = p.Sbuf() + ((size_t)c0 * 4 + vsl) * 1024 + lane * 8;
    bf16x8 Sb[2];
    Sb[0] = *(const bf16x8*)sp;
    Sb[1] = *(const bf16x8*)(sp + 512);
    scan_steps<7>(p.chunk() + (size_t)c0 * 24576, 24576, 16384, 20480, Sb, sp + 4096, 4096, vsl, lane);
  }
}

struct GdnFrag { bf16x8 w[8], q[8], a[8], m[8], sb0, sb1; BF8 u0, u1, b0, b1; };

DEVFN void gdn_load(GdnFrag& f, const Params& p, int ci, int vsl, int lane) {
  const int kq = lane >> 4, l15 = lane & 15;
  const u16* cb = p.chunk() + (size_t)ci * 24576;
  const u16* sp = p.Sbuf() + ((size_t)ci * 4 + vsl) * 1024 + lane * 8;
  f.sb0 = *(const bf16x8*)sp; f.sb1 = *(const bf16x8*)(sp + 512);
  f.u0.q = *(const uint4*)(cb + 12288 + (vsl * 64 + lane) * 16);
  f.u1.q = *(const uint4*)(cb + 12288 + (vsl * 64 + lane) * 16 + 8);
#pragma unroll
  for (int mt = 0; mt < 4; ++mt) {
    const u16* r_ = cb + (mt * 16 + l15) * 64 + kq * 8;
    f.w[mt * 2] = *(const bf16x8*)r_; f.w[mt * 2 + 1] = *(const bf16x8*)(r_ + 32);
    f.q[mt * 2] = *(const bf16x8*)(r_ + 4096); f.q[mt * 2 + 1] = *(const bf16x8*)(r_ + 4096 + 32);
    f.a[mt * 2] = *(const bf16x8*)(r_ + 8192); f.a[mt * 2 + 1] = *(const bf16x8*)(r_ + 8192 + 32);
  }
}

DEVFN void gdn_mfma(const GdnFrag& f, f32x4 (&O)[4]) {
  f32x4 vn[4];
#pragma unroll
  for (int mt = 0; mt < 4; ++mt) {
    f32x4 c = f32x4{0.f, 0.f, 0.f, 0.f};
    c = MFMA16(f.w[mt * 2], f.sb0, c);
    c = MFMA16(f.w[mt * 2 + 1], f.sb1, c);
    const BF8& uu = (mt >> 1) ? f.u1 : f.u0;
    const unsigned u0 = uu.u[(mt & 1) * 2], u1 = uu.u[(mt & 1) * 2 + 1];
    vn[mt][0] = __uint_as_float(u0 << 16) - c[0];
    vn[mt][1] = __uint_as_float(u0 & 0xffff0000u) - c[1];
    vn[mt][2] = __uint_as_float(u1 << 16) - c[2];
    vn[mt][3] = __uint_as_float(u1 & 0xffff0000u) - c[3];
  }
  const bf16x8 Vb0 = pack8(vn[0], vn[1]), Vb1 = pack8(vn[2], vn[3]);
#pragma unroll
  for (int mt = 0; mt < 4; ++mt) {
    f32x4 c = f32x4{0.f, 0.f, 0.f, 0.f};
    c = MFMA16(f.q[mt * 2], f.sb0, c);
    c = MFMA16(f.q[mt * 2 + 1], f.sb1, c);
    c = MFMA16(f.a[mt * 2], Vb0, c);
    c = MFMA16(f.a[mt * 2 + 1], Vb1, c);
    O[mt] = c;
  }
}

DEVFN void gdn_epi(const Params& p, int ci, const f32x4 (&O)[4], float* red, int vsl, int lane) {
  const int kq = lane >> 4, l15 = lane & 15;
  const int n = ci & 127, bh = ci >> 7, h = bh & 7, b = bh >> 3;
  const int row0 = b * 8192 + n * 64;
  const int v = vsl * 16 + l15;
  u16* zbase = (u16*)p.out + 16777216 + (size_t)(row0 + kq * 4) * 1024 + 512 + h * 64 + v;
  u16 zv[16];
#pragma unroll
  for (int mt = 0; mt < 4; ++mt)
#pragma unroll
    for (int r = 0; r < 4; ++r) {
      zv[mt * 4 + r] = zbase[(size_t)(mt * 16 + r) * 1024];
      float ss = O[mt][r] * O[mt][r];
      ss += __shfl_xor(ss, 1); ss += __shfl_xor(ss, 2); ss += __shfl_xor(ss, 4); ss += __shfl_xor(ss, 8);
      if (l15 == 0) red[vsl * 64 + mt * 16 + kq * 4 + r] = ss;
    }
  __syncthreads();
  const float gw = p.gdn_norm_w[v];
#pragma unroll
  for (int mt = 0; mt < 4; ++mt)
#pragma unroll
    for (int r = 0; r < 4; ++r) {
      const int c = mt * 16 + kq * 4 + r;
      const float tot = red[c] + red[64 + c] + red[128 + c] + red[192 + c];
      const float rstd = rsqrtf(tot * (1.f / 64.f) + EPS);
      zbase[(size_t)(mt * 16 + r) * 1024] = f2bf(O[mt][r] * rstd * gw * bf2f(zv[mt * 4 + r]));
    }
  __syncthreads();
}


DEVFN void gdn_load_mb(GdnFrag& f, const Params& p, int ci, int vsl, int lane) {
  const int kq = lane >> 4, l15 = lane & 15;
  const u16* cb = p.chunk() + (size_t)ci * 24576;
  f.u0.q = *(const uint4*)(cb + 12288 + (vsl * 64 + lane) * 16);
  f.u1.q = *(const uint4*)(cb + 12288 + (vsl * 64 + lane) * 16 + 8);
  f.b0.q = *(const uint4*)(cb + 20480 + (vsl * 64 + lane) * 16);
  f.b1.q = *(const uint4*)(cb + 20480 + (vsl * 64 + lane) * 16 + 8);
#pragma unroll
  for (int mt = 0; mt < 4; ++mt) {
    const u16* r_ = cb + (mt * 16 + l15) * 64 + kq * 8;
    f.w[mt * 2] = *(const bf16x8*)r_; f.w[mt * 2 + 1] = *(const bf16x8*)(r_ + 32);
    f.q[mt * 2] = *(const bf16x8*)(r_ + 4096); f.q[mt * 2 + 1] = *(const bf16x8*)(r_ + 4096 + 32);
    f.a[mt * 2] = *(const bf16x8*)(r_ + 8192); f.a[mt * 2 + 1] = *(const bf16x8*)(r_ + 8192 + 32);
    f.m[mt * 2] = *(const bf16x8*)(r_ + 16384); f.m[mt * 2 + 1] = *(const bf16x8*)(r_ + 16384 + 32);
  }
}
DEVFN void gdn_advance(const GdnFrag& f, bf16x8& s0, bf16x8& s1) {
  f32x4 acc[4];
#pragma unroll
  for (int mt = 0; mt < 4; ++mt) {
    const BF8& bb = (mt >> 1) ? f.b1 : f.b0;
    const unsigned u0 = bb.u[(mt & 1) * 2], u1 = bb.u[(mt & 1) * 2 + 1];
    f32x4 c;
    c[0] = __uint_as_float(u0 << 16); c[1] = __uint_as_float(u0 & 0xffff0000u);
    c[2] = __uint_as_float(u1 << 16); c[3] = __uint_as_float(u1 & 0xffff0000u);
    c = MFMA16(f.m[mt * 2], s0, c);
    c = MFMA16(f.m[mt * 2 + 1], s1, c);
    acc[mt] = c;
  }
  s0 = pack8(acc[0], acc[1]);
  s1 = pack8(acc[2], acc[3]);
}

DEVFN void phase_gdn_out(const Params& p, char* smem) {
  const int tid = get_tid(), lane = tid & 63, wave = tid >> 6;
  float* red = (float*)smem;
  const int vsl = wave;
  if (gridDim.x == 512) {
    const int kq = lane >> 4, l15 = lane & 15;
    const int task = blockIdx.x >> 1, hs = blockIdx.x & 1;
    const int cg = (task >> 4) * 128 + (task & 15) * 8;
    const int c0 = cg + 4 * hs;
    u16* lds0 = (u16*)smem;
    float* red2 = (float*)(smem + 65536);
    const int row_w = tid >> 3, ch_w = tid & 7;
    const int woff = row_w * 64 + ((ch_w ^ ((row_w >> 1) & 7)) << 3);
    const int fsw = (l15 >> 1) & 7;
    u32x4s rg[2][8];
    BF8 ru[2][2], rq[2][2];
#define GO_LOAD(slot, ci_)                                                                    \
    {                                                                                          \
      const u16* cb_ = p.chunk() + (size_t)(ci_) * 24576;                                      \
      rg[slot][0] = *(const u32x4s*)(cb_ + tid * 8);                                           \
      rg[slot][1] = *(const u32x4s*)(cb_ + (tid + 256) * 8);                                   \
      rg[slot][2] = *(const u32x4s*)(cb_ + 4096 + tid * 8);                                    \
      rg[slot][3] = *(const u32x4s*)(cb_ + 4096 + (tid + 256) * 8);                            \
      rg[slot][4] = *(const u32x4s*)(cb_ + 8192 + tid * 8);                                    \
      rg[slot][5] = *(const u32x4s*)(cb_ + 8192 + (tid + 256) * 8);                            \
      rg[slot][6] = *(const u32x4s*)(cb_ + 16384 + tid * 8);                                   \
      rg[slot][7] = *(const u32x4s*)(cb_ + 16384 + (tid + 256) * 8);                           \
      ru[slot][0].q = *(const uint4*)(cb_ + 12288 + (vsl * 64 + lane) * 16);                   \
      ru[slot][1].q = *(const uint4*)(cb_ + 12288 + (vsl * 64 + lane) * 16 + 8);               \
      rq[slot][0].q = *(const uint4*)(cb_ + 20480 + (vsl * 64 + lane) * 16);                   \
      rq[slot][1].q = *(const uint4*)(cb_ + 20480 + (vsl * 64 + lane) * 16 + 8);               \
    }
#define GO_FRAG(lb_, k_, mt_, ks_) (*(const bf16x8*)((lb_) + (k_) * 4096 + ((mt_) * 16 + l15) * 64 + ((((ks_) * 4 + kq) ^ fsw) << 3)))
    GO_LOAD(0, c0)
    GO_LOAD(1, c0 + 1)
    const u16* sp = p.Sbuf() + ((size_t)cg * 4 + vsl) * 1024 + lane * 8;
    bf16x8 Sb[2];
    Sb[0] = *(const bf16x8*)sp;
    Sb[1] = *(const bf16x8*)(sp + 512);
    if (hs) scan_steps<1, false>((const u16*)(p.ws + GHALF_OFF) + (size_t)task * 8192, 0, 0, 4096, Sb, nullptr, 0, vsl, lane);
#pragma unroll
    for (int it = 0; it < 4; ++it) {
      const int sl = it & 1;
      const int ci = c0 + it;
      u16* lb = lds0 + sl * 16384;
#pragma unroll
      for (int k = 0; k < 4; ++k) {
        *(u32x4s*)(lb + k * 4096 + woff) = rg[sl][2 * k];
        *(u32x4s*)(lb + k * 4096 + woff + 32 * 64) = rg[sl][2 * k + 1];
      }
      const BF8 u0 = ru[sl][0], u1 = ru[sl][1], q0 = rq[sl][0], q1 = rq[sl][1];
      __syncthreads();
      if (it + 2 < 4) GO_LOAD(sl, ci + 2)
      f32x4 vn[4];
#pragma unroll
      for (int mt = 0; mt < 4; ++mt) {
        f32x4 c = f32x4{0.f, 0.f, 0.f, 0.f};
        c = MFMA16(GO_FRAG(lb, 0, mt, 0), Sb[0], c);
        c = MFMA16(GO_FRAG(lb, 0, mt, 1), Sb[1], c);
        const BF8& uu = (mt >> 1) ? u1 : u0;
        const unsigned a0 = uu.u[(mt & 1) * 2], a1 = uu.u[(mt & 1) * 2 + 1];
        vn[mt][0] = __uint_as_float(a0 << 16) - c[0];
        vn[mt][1] = __uint_as_float(a0 & 0xffff0000u) - c[1];
        vn[mt][2] = __uint_as_float(a1 << 16) - c[2];
        vn[mt][3] = __uint_as_float(a1 & 0xffff0000u) - c[3];
      }
      const bf16x8 Vb0 = pack8(vn[0], vn[1]), Vb1 = pack8(vn[2], vn[3]);
      f32x4 O[4];
#pragma unroll
      for (int mt = 0; mt < 4; ++mt) {
        f32x4 c = f32x4{0.f, 0.f, 0.f, 0.f};
        c = MFMA16(GO_FRAG(lb, 1, mt, 0), Sb[0], c);
        c = MFMA16(GO_FRAG(lb, 1, mt, 1), Sb[1], c);
        c = MFMA16(GO_FRAG(lb, 2, mt, 0), Vb0, c);
        c = MFMA16(GO_FRAG(lb, 2, mt, 1), Vb1, c);
        O[mt] = c;
      }
      if (it < 3) {
        f32x4 acc[4];
#pragma unroll
        for (int mt = 0; mt < 4; ++mt) {
          const BF8& bb = (mt >> 1) ? q1 : q0;
          const unsigned a0 = bb.u[(mt & 1) * 2], a1 = bb.u[(mt & 1) * 2 + 1];
          f32x4 c;
          c[0] = __uint_as_float(a0 << 16); c[1] = __uint_as_float(a0 & 0xffff0000u);
          c[2] = __uint_as_float(a1 << 16); c[3] = __uint_as_float(a1 & 0xffff0000u);
          c = MFMA16(GO_FRAG(lb, 3, mt, 0), Sb[0], c);
          c = MFMA16(GO_FRAG(lb, 3, mt, 1), Sb[1], c);
          acc[mt] = c;
        }
        Sb[0] = pack8(acc[0], acc[1]);
        Sb[1] = pack8(acc[2], acc[3]);
      }
      gdn_epi(p, ci, O, red2, vsl, lane);
    }
#undef GO_LOAD
#undef GO_FRAG
  } else {
    for (int ci = blockIdx.x; ci < 2048; ci += gridDim.x) {
      GdnFrag f;
      gdn_load(f, p, ci, vsl, lane);
      f32x4 O[4];
      gdn_mfma(f, O);
      gdn_epi(p, ci, O, red, vsl, lane);
    }
  }
}

DEVFN void phase3a(const Params& p, char* smem) {
  u16* out16 = (u16*)p.out;
  u16* T = (u16*)smem;
  for (int t = blockIdx.x; t < 512; t += gridDim.x) {
    int mt_ = t & 63, nt_ = t >> 6;
    if (gridDim.x == 512) {
      const int xcd = blockIdx.x & 7, j = blockIdx.x >> 3;
      mt_ = xcd * 8 + (j & 7);
      nt_ = j >> 3;
    }
    const int row0 = mt_ * 256, n0 = nt_ * 128;
#pragma unroll 1
    for (int half = 0; half < 2; ++half) {
      const int tid = get_tid(), lane = tid & 63, wave = tid >> 6, wr = wave >> 1, wc = wave & 1;
      const int kq = lane >> 4, l15 = lane & 15;
      f32x4 acc[8][4];
      zero_acc(acc);
      gemm_core(out16 + 16777216 + (size_t)row0 * 1024 + half * 512, 1024,
                (half ? p.WtUpB() : p.WtUpA()) + (size_t)n0 * 512, 512, 512, (u16*)smem, acc);
      u16* ytmp = half ? p.Pg() : p.merged();
#pragma unroll
      for (int mt = 0; mt < 8; ++mt)
#pragma unroll
        for (int r = 0; r < 4; ++r) {
          const int lrow = wr * 128 + mt * 16 + kq * 4 + r;
          stage4(T + lrow * 136 + wc * 64 + l15, acc[mt][0][r], acc[mt][1][r], acc[mt][2][r], acc[mt][3][r]);
        }
      __syncthreads();
#pragma unroll
      for (int i = 0; i < 16; ++i) {
        const int id = tid + 256 * i, lrow = id >> 4, pc = id & 15;
        *(uint4*)(ytmp + (size_t)(row0 + lrow) * 1024 + n0 + pc * 8) = *(const uint4*)(T + lrow * 136 + pc * 8);
      }
      __syncthreads();
      zero_acc(acc);
      gemm_core(out16 + (size_t)row0 * 1024, 1024, p.WtIn() + (size_t)(7168 + half * 1024 + n0) * 1024, 1024, 1024, (u16*)smem, acc);
#pragma unroll
      for (int mt = 0; mt < 8; ++mt)
#pragma unroll
        for (int r = 0; r < 4; ++r) {
          const int lrow = wr * 128 + mt * 16 + kq * 4 + r;
          stage4(T + lrow * 136 + wc * 64 + l15, sigm(acc[mt][0][r]), sigm(acc[mt][1][r]), sigm(acc[mt][2][r]), sigm(acc[mt][3][r]));
        }
      __syncthreads();
#pragma unroll 4
      for (int i = 0; i < 16; ++i) {
        const int id = tid + 256 * i, lrow = id >> 4, pc = id & 15;
        BF8 gt, y, m;
        gt.q = *(const uint4*)(T + lrow * 136 + pc * 8);
        y.q = *(const uint4*)(ytmp + (size_t)(row0 + lrow) * 1024 + n0 + pc * 8);
        u16* dst = p.merged() + (size_t)(row0 + lrow) * 1024 + n0 + pc * 8;
        if (half) m.q = *(const uint4*)dst; else m.q = make_uint4(0, 0, 0, 0);
#pragma unroll
        for (int e = 0; e < 4; ++e) {
          const float a0 = __uint_as_float(gt.u[e] << 16) * __uint_as_float(y.u[e] << 16) + __uint_as_float(m.u[e] << 16);
          const float a1 = __uint_as_float(gt.u[e] & 0xffff0000u) * __uint_as_float(y.u[e] & 0xffff0000u) + __uint_as_float(m.u[e] & 0xffff0000u);
          m.u[e] = pack2(a0, a1);
        }
        *(uint4*)dst = m.q;
      }
      __syncthreads();
    }
  }
}

DEVFN void phase3b(const Params& p, char* smem) {
  u16* T = (u16*)smem;
  u16* dl = p.Pg();
  for (int t = blockIdx.x; t < 512; t += gridDim.x) {
    int mt_ = t & 63, nt_ = t >> 6;
    if (gridDim.x == 512) {
      const int xcd = blockIdx.x & 7, j = blockIdx.x >> 3;
      mt_ = xcd * 8 + (j & 7);
      nt_ = j >> 3;
    }
    const int row0 = mt_ * 256, n0 = nt_ * 128;
    f32x4 acc[8][4];
    zero_acc(acc);
    gemm_core(p.merged() + (size_t)row0 * 1024, 1024, p.WtOut() + (size_t)n0 * 1024, 1024, 1024, (u16*)smem, acc);
    const int tid = get_tid(), lane = tid & 63, wave = tid >> 6, wr = wave >> 1, wc = wave & 1;
    const int kq = lane >> 4, l15 = lane & 15;
#pragma unroll
    for (int mt = 0; mt < 8; ++mt)
#pragma unroll
      for (int r = 0; r < 4; ++r) {
        const int lrow = wr * 128 + mt * 16 + kq * 4 + r;
        stage4(T + lrow * 136 + wc * 64 + l15, acc[mt][0][r], acc[mt][1][r], acc[mt][2][r], acc[mt][3][r]);
      }
    __syncthreads();
#pragma unroll
    for (int i = 0; i < 16; ++i) {
      const int id = tid + 256 * i, lrow = id >> 4, pc = id & 15;
      *(uint4*)(dl + (size_t)(row0 + lrow) * 1024 + n0 + pc * 8) = *(const uint4*)(T + lrow * 136 + pc * 8);
    }
    __syncthreads();
  }
}

DEVFN void phase4(const Params& p) {
  const int tid = get_tid(), lane = tid & 63, wave = tid >> 6;
  float4 fw[4];
#pragma unroll
  for (int i4 = 0; i4 < 4; ++i4) fw[i4] = ((const float4*)p.final_norm_w)[lane + 64 * i4];
  const u16* dl = p.Pg();
  for (int row = blockIdx.x * 4 + wave; row < 16384; row += gridDim.x * 4) {
    const float4* xr = (const float4*)(p.x + (size_t)row * 1024);
    const uint2* dr = (const uint2*)(dl + (size_t)row * 1024);
    float4 v[4];
    float ss = 0.f;
#pragma unroll
    for (int i4 = 0; i4 < 4; ++i4) {
      const float4 xv = xr[lane + 64 * i4];
      const uint2 d = dr[lane + 64 * i4];
      float4 t;
      t.x = xv.x + __uint_as_float(d.x << 16); t.y = xv.y + __uint_as_float(d.x & 0xffff0000u);
      t.z = xv.z + __uint_as_float(d.y << 16); t.w = xv.w + __uint_as_float(d.y & 0xffff0000u);
      v[i4] = t;
      ss += t.x * t.x + t.y * t.y + t.z * t.z + t.w * t.w;
    }
#pragma unroll
    for (int o = 32; o >= 1; o >>= 1) ss += __shfl_xor(ss, o);
    const float rs = __builtin_amdgcn_rsqf(ss * (1.f / 1024.f) + EPS);
    float4* o = (float4*)(p.out + (size_t)row * 1024);
#pragma unroll
    for (int i4 = 0; i4 < 4; ++i4) {
      float4 t = v[i4];
      t.x *= rs * fw[i4].x; t.y *= rs * fw[i4].y; t.z *= rs * fw[i4].z; t.w *= rs * fw[i4].w;
      o[lane + 64 * i4] = t;
    }
  }
}

#ifndef NO_MEGA
__global__ void __launch_bounds__(256, 2) fwd_megakernel(Params p) {
  __shared__ __attribute__((aligned(16))) char smem[SMEM_BYTES];
  __shared__ uint4 xb_words;
  cg::grid_group grid = cg::this_grid();
  if (threadIdx.x == 0) xb_words = make_uint4(0u, 0u, 0u, 0u);
  __syncthreads();
  if (p.ws == nullptr) grid.sync();
  XcdBarrier xb = xcd_barrier_post((unsigned*)(p.ws + 245956608ull), (volatile LAS unsigned*)&xb_words);
  phase0(p, smem);
  xcd_barrier(xb);
  phase1(p, smem);
  xcd_barrier(xb);
  phase_attn(p, smem);
  xcd_barrier(xb);
  phase_chunk(p, smem);
  xcd_barrier(xb);
  phase_scan_x1(p, smem);
  xcd_barrier(xb);
  phase_scan_merge(p, smem);
  xcd_barrier(xb);
  if (gridDim.x != 512) {
    phase_scan_x3(p);
    xcd_barrier(xb);
  }
  phase_gdn_out(p, smem);
  xcd_barrier(xb);
  phase3a(p, smem);
  xcd_barrier(xb);
  phase3b(p, smem);
  xcd_barrier(xb);
  phase4(p);
}

extern "C" void kernel_launch(void* const* d_in, const int* in_sizes, int n_in, void* d_out, int out_size,
                              void* d_ws, size_t ws_size, hipStream_t stream) {
  static int grid_blocks = 0;
  if (!grid_blocks) {
    int dev = 0, cus = 0, per_cu = 0;
    (void)hipGetDevice(&dev);
    (void)hipDeviceGetAttribute(&cus, hipDeviceAttributeMultiprocessorCount, dev);
    (void)hipOccupancyMaxActiveBlocksPerMultiprocessor(&per_cu, fwd_megakernel, NT, 0);
    if (per_cu > 2) per_cu = 2;
    if (per_cu < 1) per_cu = 1;
    grid_blocks = cus * per_cu;
  }
  Params p{};
  p.x = (const float*)d_in[0]; p.norm_w = (const float*)d_in[1]; p.w_in = (const float*)d_in[2];
  p.conv_w = (const float*)d_in[3]; p.a_log = (const float*)d_in[4]; p.dt_bias = (const float*)d_in[5];
  p.gdn_norm_w = (const float*)d_in[6]; p.w_up_a = (const float*)d_in[7]; p.w_up_b = (const float*)d_in[8];
  p.w_out = (const float*)d_in[9]; p.final_norm_w = (const float*)d_in[10];
  p.out = (float*)d_out;
  p.ws = (char*)d_ws;
  (void)hipMemsetAsync((char*)d_ws + 245956608ull, 0, XCD_BAR_WORDS * sizeof(unsigned), stream);
  void* args[] = {&p};
  hipError_t e = hipLaunchCooperativeKernel((void*)fwd_megakernel, dim3(grid_blocks), dim3(NT), args, 0, stream);
  if (e != hipSuccess) fprintf(stderr, "cooperative launch failed: %s (grid %d)\n", hipGetErrorString(e), grid_blocks);
}
#endif
```

```cpp
#include <hip/hip_runtime.h>
#include <hip/hip_cooperative_groups.h>
#include <stdint.h>
#include <stdio.h>
namespace cg = cooperative_groups;

typedef __attribute__((ext_vector_type(8))) short bf16x8;
typedef __attribute__((ext_vector_type(4))) float f32x4;
typedef unsigned short u16;

#define DEVFN __device__ __forceinline__

constexpr int SEQ = 8192, NWIN = 9232;
constexpr float EPS = 1e-6f;
constexpr int NT = 256;
constexpr int SMEM_BYTES = 73728;

#define DEVFN_ __device__ __forceinline__
struct Params {
  const float *x, *norm_w, *w_in, *conv_w, *a_log, *dt_bias, *gdn_norm_w, *w_up_a, *w_up_b, *w_out, *final_norm_w;
  float* out;
  char* ws;
  DEVFN_ u16* Qp() const { return (u16*)(ws); }
  DEVFN_ u16* Kp() const { return (u16*)(ws + 50331648ull); }
  DEVFN_ u16* Vt() const { return (u16*)(ws + 100663296ull); }
  DEVFN_ u16* Pg() const { return (u16*)(ws + 150994944ull); }
  DEVFN_ u16* WtIn() const { return (u16*)(ws + 201326592ull); }
  DEVFN_ u16* WtUpA() const { return (u16*)(ws + 220200960ull); }
  DEVFN_ u16* WtUpB() const { return (u16*)(ws + 221249536ull); }
  DEVFN_ u16* WtOut() const { return (u16*)(ws + 222298112ull); }
  DEVFN_ float* ropeC() const { return (float*)(ws + 224395264ull); }
  DEVFN_ float* ropeS() const { return (float*)(ws + 225443840ull); }
  DEVFN_ float* bg() const { return (float*)(ws + 226492416ull); }
  DEVFN_ float* lse() const { return (float*)(ws + 227540992ull); }
  DEVFN_ float* rowss() const { return (float*)(ws + 229113856ull); }
  DEVFN_ u16* Sbuf() const { return (u16*)(ws + 229179392ull); }
  DEVFN_ u16* chunk() const { return Kp(); }
  DEVFN_ u16* merged() const { return Qp(); }
};

DEVFN int get_tid() { int t = threadIdx.x; asm volatile("" : "+v"(t)); return t; }
typedef __attribute__((ext_vector_type(2))) __bf16 bf16x2_t;
typedef __attribute__((ext_vector_type(2))) float f32x2_t;
DEVFN unsigned pack2(float a, float b) {
  f32x2_t v = {a, b};
  bf16x2_t r = __builtin_convertvector(v, bf16x2_t);
  return __builtin_bit_cast(unsigned, r);
}
DEVFN u16 f2bf(float f) { return (u16)(pack2(f, 0.f) & 0xffffu); }
DEVFN float bf2f(u16 h) { return __uint_as_float(((unsigned)h) << 16); }
DEVFN float sigm(float x) { return __builtin_amdgcn_rcpf(1.f + __expf(-x)); }
DEVFN float silu(float x) { return x * __builtin_amdgcn_rcpf(1.f + __expf(-x)); }
DEVFN void stage4(u16* trow, float v0, float v1, float v2, float v3) {
  const unsigned p01 = pack2(v0, v1), p23 = pack2(v2, v3);
  trow[0] = (u16)(p01 & 0xffffu); trow[16] = (u16)(p01 >> 16);
  trow[32] = (u16)(p23 & 0xffffu); trow[48] = (u16)(p23 >> 16);
}

DEVFN float row16_sum(float x) {
  x += __builtin_bit_cast(float, __builtin_amdgcn_update_dpp(0, __builtin_bit_cast(int, x), 0x128, 0xF, 0xF, false));
  x += __builtin_bit_cast(float, __builtin_amdgcn_update_dpp(0, __builtin_bit_cast(int, x), 0x124, 0xF, 0xF, false));
  x += __builtin_bit_cast(float, __builtin_amdgcn_update_dpp(0, __builtin_bit_cast(int, x), 0x122, 0xF, 0xF, false));
  x += __builtin_bit_cast(float, __builtin_amdgcn_update_dpp(0, __builtin_bit_cast(int, x), 0x121, 0xF, 0xF, false));
  return x;
}

DEVFN int permk(int j) { return (j & 32) | ((j & 12) << 1) | ((j & 16) >> 2) | (j & 3); }

union BF8 { bf16x8 v; unsigned u[4]; uint4 q; };

DEVFN bf16x8 pack8(const f32x4& a, const f32x4& b) {
  BF8 r;
  r.u[0] = pack2(a[0], a[1]); r.u[1] = pack2(a[2], a[3]);
  r.u[2] = pack2(b[0], b[1]); r.u[3] = pack2(b[2], b[3]);
  return r.v;
}

#define MFMA16(a, b, c) __builtin_amdgcn_mfma_f32_16x16x32_bf16((a), (b), (c), 0, 0, 0)
#define MFMAF32(a, b, c) __builtin_amdgcn_mfma_f32_16x16x4f32((a), (b), (c), 0, 0, 0)

#define XB_TMO      128
#define XB_XCNT(j)  (256  + 64 * (j))
#define XB_XSUB(j)  (1280 + 64 * (j))
#define XB_XGEN(j)  (2304 + 64 * (j))
#define XB_TOP      3328
#define XB_TOPGEN   3392
#define XCD_BAR_WORDS 3456
#define XB_SPIN_CAP (1u << 18)
#define LAS __attribute__((address_space(3)))

__device__ __forceinline__ unsigned xb_ld(unsigned* p)              { return __hip_atomic_load(p, __ATOMIC_RELAXED, __HIP_MEMORY_SCOPE_AGENT); }
__device__ __forceinline__ unsigned xb_add(unsigned* p, unsigned v) { return __hip_atomic_fetch_add(p, v, __ATOMIC_RELAXED, __HIP_MEMORY_SCOPE_AGENT); }
__device__ __forceinline__ unsigned xb_xcc_id() { return (unsigned)__builtin_amdgcn_s_getreg((3 << 11) | 20) & 0xFu; }
#define XB_SPIN(cond, bar) do { unsigned _sp = 0; while (cond) { __builtin_amdgcn_s_sleep(1); \
    if ((++_sp & 255u) == 0u) { if (xb_ld(&(bar)[XB_TMO])) break; if (_sp > XB_SPIN_CAP) { atomicAdd(&(bar)[XB_TMO], 1u); break; } } } } while (0)

struct XcdBarrier {
    unsigned* bar; unsigned x;
    volatile LAS unsigned* st;
};

__device__ __forceinline__ XcdBarrier xcd_barrier_post(unsigned* bar, volatile LAS unsigned* st) {
    XcdBarrier b; b.bar = bar; b.x = xb_xcc_id(); b.st = st;
    if (threadIdx.x == 0) (void)xb_add(&bar[XB_XCNT(b.x)], 1u);
    return b;
}
__device__ __forceinline__ void xcd_barrier_complete(unsigned* bar, unsigned x, unsigned& nloc, unsigned& nx) {
    const unsigned G = gridDim.x * gridDim.y * gridDim.z;
    unsigned sum, cnt, mine, sp = 0u;
    for (;;) {
        sum = 0u; cnt = 0u; mine = 0u;
#pragma unroll
        for (unsigned j = 0; j < 16; ++j) { const unsigned c = xb_ld(&bar[XB_XCNT(j)]); sum += c; cnt += (c > 0u) ? 1u : 0u; mine = (j == x) ? c : mine; }
        if (sum == G) break;
        __builtin_amdgcn_s_sleep(1);
        if ((++sp & 255u) == 0u) { if (xb_ld(&bar[XB_TMO])) break; if (sp > XB_SPIN_CAP) { atomicAdd(&bar[XB_TMO], 1u); break; } }
    }
    nloc = mine > 0u ? mine : 1u; nx = cnt > 0u ? cnt : 1u;
}

__device__ __forceinline__ void xcd_barrier(const XcdBarrier& b) {
    asm volatile("s_waitcnt vmcnt(0)" ::: "memory");
    __syncthreads();
    if (threadIdx.x == 0) {
        unsigned* bar = b.bar;
        __builtin_amdgcn_s_waitcnt(0);
        unsigned nloc = b.st[0], nx = b.st[1];
        if (nloc == 0u) { xcd_barrier_complete(bar, b.x, nloc, nx); b.st[0] = nloc; b.st[1] = nx; }
        const unsigned old = xb_add(&bar[XB_XSUB(b.x)], 1u);
        const unsigned gen = old / nloc;
        if (old + 1u == (gen + 1u) * nloc) {
            __builtin_amdgcn_fence(__ATOMIC_RELEASE, "agent");
            asm volatile("s_waitcnt vmcnt(0)" ::: "memory");
            const unsigned og = xb_add(&bar[XB_TOP], 1u);
            const unsigned tg = og / nx;
            if (og + 1u == (tg + 1u) * nx) xb_add(&bar[XB_TOPGEN], 1u);
            else XB_SPIN(xb_ld(&bar[XB_TOPGEN]) == tg, bar);
            __builtin_amdgcn_fence(__ATOMIC_ACQUIRE, "agent");
            xb_add(&bar[XB_XGEN(b.x)], 1u);
            asm volatile("s_waitcnt vmcnt(0)" ::: "memory");
        } else {
            XB_SPIN(xb_ld(&bar[XB_XGEN(b.x)]) == gen, bar);
            __builtin_amdgcn_fence(__ATOMIC_ACQUIRE, "agent");
            asm volatile("s_waitcnt vmcnt(0)" ::: "memory");
        }
    }
    __syncthreads();
}


DEVFN void gemm_core(const u16* __restrict__ A, int lda, const u16* __restrict__ B, int ldb, int K,
                     u16* sm, f32x4 (&acc)[8][4]) {
  const int tid = get_tid(), lane = tid & 63, wave = tid >> 6, wr = wave >> 1, wc = wave & 1;
  const int lrow = tid >> 2, lc = tid & 3;
  const int wofs = lrow * 32 + ((lc ^ ((4 - ((lrow >> 2) & 3)) & 3)) << 3);
  const int l15 = lane & 15, kq = lane >> 4;
  const int co = ((kq ^ ((4 - (l15 >> 2)) & 3)) << 3);
  uint4 ra0_0, ra0_1, ra0_2, ra0_3, rb0_0, rb0_1, ra1_0, ra1_1, ra1_2, ra1_3, rb1_0, rb1_1;
  const u16* Ap = A + (size_t)lrow * lda + lc * 8;
  const u16* Bp = B + (size_t)lrow * ldb + lc * 8;
#define G_LOADA(RA, k0, i) RA##_##i = *(const uint4*)(Ap + (size_t)(64 * i) * lda + (k0));
#define G_LOADB(RB, k0, i) RB##_##i = *(const uint4*)(Bp + (size_t)(64 * i) * ldb + (k0));
#define G_LOAD(RA, RB, k0) G_LOADA(RA, k0, 0) G_LOADA(RA, k0, 1) G_LOADA(RA, k0, 2) G_LOADA(RA, k0, 3) G_LOADB(RB, k0, 0) G_LOADB(RB, k0, 1)
#define G_STOREA(RA, buf, i) *(uint4*)(sm + (buf) * 12288 + 64 * i * 32 + wofs) = RA##_##i;
#define G_STOREB(RB, buf, i) *(uint4*)(sm + (buf) * 12288 + 8192 + 64 * i * 32 + wofs) = RB##_##i;
#define G_STORE(RA, RB, buf) G_STOREA(RA, buf, 0) G_STOREA(RA, buf, 1) G_STOREA(RA, buf, 2) G_STOREA(RA, buf, 3) G_STOREB(RB, buf, 0) G_STOREB(RB, buf, 1)
#define G_COMPUTE(buf)                                                                         \
  {                                                                                            \
    const u16* as = sm + (buf) * 12288 + (wr * 128 + l15) * 32 + co;                           \
    const u16* bs = sm + (buf) * 12288 + 8192 + (wc * 64 + l15) * 32 + co;                     \
    bf16x8 b[4];                                                                               \
    _Pragma("unroll") for (int nt = 0; nt < 4; ++nt) b[nt] = *(const bf16x8*)(bs + nt * 512); \
    bf16x8 a[8];                                                                               \
    _Pragma("unroll") for (int mt = 0; mt < 8; ++mt) a[mt] = *(const bf16x8*)(as + mt * 512);  \
    __builtin_amdgcn_s_setprio(1);                                                             \
    _Pragma("unroll") for (int mt = 0; mt < 8; ++mt) {                                         \
      _Pragma("unroll") for (int nt = 0; nt < 4; ++nt) acc[mt][nt] = MFMA16(a[mt], b[nt], acc[mt][nt]); \
    }                                                                                          \
    __builtin_amdgcn_s_setprio(0);                                                             \
  }
  const int nk = K >> 5;
  G_LOAD(ra0, rb0, 0)
  G_LOAD(ra1, rb1, 32)
  G_STORE(ra0, rb0, 0)
  __syncthreads();
#pragma unroll 1
  for (int kt = 0; kt < nk; kt += 2) {
    const int k2 = (kt + 2 < nk ? kt + 2 : nk - 1) * 32, k3 = (kt + 3 < nk ? kt + 3 : nk - 1) * 32;
    G_LOAD(ra0, rb0, k2)
    G_COMPUTE(0)
    G_STORE(ra1, rb1, 1)
    __syncthreads();
    G_LOAD(ra1, rb1, k3)
    G_COMPUTE(1)
    G_STORE(ra0, rb0, 0)
    __syncthreads();
  }
#undef G_LOAD
#undef G_STORE
#undef G_LOADA
#undef G_LOADB
#undef G_STOREA
#undef G_STOREB
#undef G_COMPUTE
}

DEVFN void zero_acc(f32x4 (&acc)[8][4]) {
#pragma unroll
  for (int i = 0; i < 8; ++i)
#pragma unroll
    for (int j = 0; j < 4; ++j) acc[i][j] = f32x4{0.f, 0.f, 0.f, 0.f};
}

DEVFN void transpose_tile(const float* __restrict__ src, int ld, int K, u16* __restrict__ dst, int k0, int n0, int nsrc, float* ts) {
  const int tid = get_tid();
#pragma unroll
  for (int i = 0; i < 4; ++i) {
    const int idx = tid + NT * i, kk = idx >> 4, n4 = (idx & 15) * 4;
    const float4 v = *(const float4*)(src + (size_t)(k0 + kk) * ld + nsrc + n4);
    ts[kk * 65 + n4 + 0] = v.x; ts[kk * 65 + n4 + 1] = v.y; ts[kk * 65 + n4 + 2] = v.z; ts[kk * 65 + n4 + 3] = v.w;
  }
  __syncthreads();
#pragma unroll
  for (int i = 0; i < 4; ++i) {
    const int idx = tid + NT * i, nn = idx >> 4, k4 = (idx & 15) * 4;
    uint2 pk;
    pk.x = pack2(ts[(k4 + 0) * 65 + nn], ts[(k4 + 1) * 65 + nn]);
    pk.y = pack2(ts[(k4 + 2) * 65 + nn], ts[(k4 + 3) * 65 + nn]);
    *(uint2*)(dst + (size_t)(n0 + nn) * K + k0 + k4) = pk;
  }
  __syncthreads();
}

DEVFN void phase0(const Params& p, char* smem) {
  const int tid = get_tid(), lane = tid & 63, wave = tid >> 6;
  const int bid = blockIdx.x, nb = gridDim.x;
  float* ts = (float*)smem;
  for (int t = bid; t < 1792; t += nb) {
    const int n0 = (t >> 4) * 64, k0 = (t & 15) * 64;
    transpose_tile(p.w_in, NWIN, 1024, p.WtIn(), k0, n0, n0, ts);
  }
  for (int idx = bid * NT + tid; idx < SEQ * 32; idx += nb * NT) {
    int pos = idx >> 5, i = idx & 31;
    float inv = powf(10000.f, -(float)i / 32.f);
    float ang = (float)pos * inv;
    double a = (double)ang;
    double n = rint(a * 0.15915494309189535);
    float r = (float)(a - n * 6.283185307179586);
    p.ropeC()[idx] = cosf(r);
    p.ropeS()[idx] = sinf(r);
    if (idx < 16384) p.rowss()[idx] = 0.f;
  }
  float* wt = (float*)smem;
  for (int idx = tid; idx < 4096; idx += NT) {
    const int k = idx & 1023, j4 = idx >> 10;
    const float4 w4 = *(const float4*)(p.w_in + (size_t)k * NWIN + 7168 + 4 * j4);
    wt[(4 * j4 + 0) * 1024 + k] = w4.x; wt[(4 * j4 + 1) * 1024 + k] = w4.y;
    wt[(4 * j4 + 2) * 1024 + k] = w4.z; wt[(4 * j4 + 3) * 1024 + k] = w4.w;
  }
  __syncthreads();
  float4 nw[4];
#pragma unroll
  for (int i4 = 0; i4 < 4; ++i4) nw[i4] = ((const float4*)p.norm_w)[lane + 64 * i4];
  u16* h16 = (u16*)p.out;
  for (int grp = bid * 4 + wave; grp < 4096; grp += nb * 4) {
    float4 hv[4][4];
#pragma unroll
    for (int r = 0; r < 4; ++r) {
      const int row = grp * 4 + r;
      const float4* xr = (const float4*)(p.x + (size_t)row * 1024);
      float ss = 0.f;
#pragma unroll
      for (int i4 = 0; i4 < 4; ++i4) {
        float4 v = xr[lane + 64 * i4];
        hv[r][i4] = v;
        ss += v.x * v.x + v.y * v.y + v.z * v.z + v.w * v.w;
      }
#pragma unroll
      for (int o = 32; o >= 1; o >>= 1) ss += __shfl_xor(ss, o);
      const float rs = rsqrtf(ss * (1.f / 1024.f) + EPS);
#pragma unroll
      for (int i4 = 0; i4 < 4; ++i4) {
        float4 v = hv[r][i4];
        v.x *= rs * nw[i4].x; v.y *= rs * nw[i4].y; v.z *= rs * nw[i4].z; v.w *= rs * nw[i4].w;
        hv[r][i4] = v;
        uint2 pk; pk.x = pack2(v.x, v.y); pk.y = pack2(v.z, v.w);
        *(uint2*)(h16 + (size_t)row * 1024 + 4 * (lane + 64 * i4)) = pk;
      }
    }
    float myval = 0.f;
    const bool up5 = (lane & 32) != 0, up4 = (lane & 16) != 0, up1 = (lane & 2) != 0, up0 = (lane & 1) != 0;
#pragma unroll 1
    for (int jj = 0; jj < 4; ++jj) {
      float a[4][4];
#pragma unroll
      for (int r = 0; r < 4; ++r)
#pragma unroll
        for (int q = 0; q < 4; ++q) a[r][q] = 0.f;
#pragma unroll
      for (int q = 0; q < 4; ++q)
#pragma unroll
        for (int i4 = 0; i4 < 4; ++i4) {
          const float4 w4 = ((const float4*)(wt + (4 * jj + q) * 1024))[lane + 64 * i4];
#pragma unroll
          for (int r = 0; r < 4; ++r)
            a[r][q] += hv[r][i4].x * w4.x + hv[r][i4].y * w4.y + hv[r][i4].z * w4.z + hv[r][i4].w * w4.w;
        }
      float b[2][4], c[4], d[2];
#pragma unroll
      for (int rr = 0; rr < 2; ++rr)
#pragma unroll
        for (int q = 0; q < 4; ++q) {
          const float send = up5 ? a[rr][q] : a[rr + 2][q], keep = up5 ? a[rr + 2][q] : a[rr][q];
          b[rr][q] = keep + __shfl_xor(send, 32);
        }
#pragma unroll
      for (int q = 0; q < 4; ++q) {
        const float send = up4 ? b[0][q] : b[1][q], keep = up4 ? b[1][q] : b[0][q];
        c[q] = keep + __shfl_xor(send, 16);
      }
#pragma unroll
      for (int qq = 0; qq < 2; ++qq) {
        const float send = up1 ? c[qq] : c[qq + 2], keep = up1 ? c[qq + 2] : c[qq];
        d[qq] = keep + __shfl_xor(send, 2);
      }
      float e;
      {
        const float send = up0 ? d[0] : d[1], keep = up0 ? d[1] : d[0];
        e = keep + __shfl_xor(send, 1);
      }
      e += __shfl_xor(e, 8);
      e += __shfl_xor(e, 4);
      if (((lane >> 2) & 3) == jj) myval = e;
    }
    {
      const int r = lane >> 4, j = lane & 15;
      const int row = grp * 4 + r;
      float val = myval, res;
      if (j < 8) res = sigm(val);
      else {
        const int hh = j - 8;
        const float z = val + p.dt_bias[hh];
        const float sp = fmaxf(z, 0.f) + log1pf(__expf(-fabsf(z)));
        res = -__expf(p.a_log[hh]) * sp;
      }
      p.bg()[(size_t)row * 16 + j] = res;
    }
  }
  __syncthreads();
}

DEVFN void phase1(const Params& p, char* smem) {
  u16* out16 = (u16*)p.out;
  u16* T = (u16*)smem;
  for (int t = blockIdx.x; t < 64 * 56; t += gridDim.x) {
    const int tid = get_tid(), lane = tid & 63, wave = tid >> 6, wr = wave >> 1, wc = wave & 1;
    const int kq = lane >> 4, l15 = lane & 15;
    int mt_ = t & 63, nt_ = t >> 6;
    if (gridDim.x == 512) {
      const int xcd = blockIdx.x & 7, j = blockIdx.x >> 3, i = t >> 9;
      mt_ = xcd * 8 + (j & 7);
      nt_ = i * 8 + (j >> 3);
    }
    const int row0 = mt_ * 256;
    f32x4 acc[8][4];
    zero_acc(acc);
    gemm_core(out16 + (size_t)row0 * 1024, 1024, p.WtIn() + (size_t)(nt_ * 128) * 1024, 1024, 1024, (u16*)smem, acc);
    const int bq = row0 >> 13;
    const int s0 = row0 & 8191;
    if (nt_ < 36) {
      const int g = nt_ / 12, tt = (nt_ % 12) >> 2;
      const int sh = 2 * g;
      if (tt < 2) {
        const float sc = (tt == 0) ? 0.18033688011112042f : 1.f;
#pragma unroll
        for (int mt = 0; mt < 8; ++mt)
#pragma unroll
          for (int r = 0; r < 4; ++r) {
            const int lrow = wr * 128 + mt * 16 + kq * 4 + r;
            const int s = s0 + lrow;
#pragma unroll
            for (int nt = 0; nt < 2; ++nt) {
              const int d = nt * 16 + l15;
              const float c = p.ropeC()[s * 32 + d], sn = p.ropeS()[s * 32 + d];
              const float lo = acc[mt][nt][r], hi = acc[mt][nt + 2][r];
              T[lrow * 136 + wc * 64 + d] = f2bf((lo * c - hi * sn) * sc);
              T[lrow * 136 + wc * 64 + d + 32] = f2bf((hi * c + lo * sn) * sc);
            }
          }
        __syncthreads();
        u16* dstb = (tt == 0 ? p.Qp() : p.Kp());
#pragma unroll
        for (int i = 0; i < 16; ++i) {
          const int id = tid + 256 * i, lrow = id >> 4, pc = id & 15;
          const uint4 v = *(const uint4*)(T + lrow * 136 + pc * 8);
          const int s = s0 + lrow;
          const int pos = ((s & ((1 << sh) - 1)) << (13 - sh)) + (s >> sh);
          const int head = ((nt_ & 3) << 1) + (pc >> 3);
          const size_t hb = (size_t)((bq * 3 + g) * 8 + head);
          *(uint4*)(dstb + (hb * 8192 + pos) * 64 + (pc & 7) * 8) = v;
        }
      } else {
#pragma unroll
        for (int mt = 0; mt < 8; ++mt)
#pragma unroll
          for (int r = 0; r < 4; ++r) {
            const int lrow = wr * 128 + mt * 16 + kq * 4 + r;
            const int rho = ((lrow & ((1 << sh) - 1)) << (8 - sh)) + (lrow >> sh);
#pragma unroll
            for (int nt = 0; nt < 4; ++nt) T[(wc * 64 + nt * 16 + l15) * 264 + rho] = f2bf(acc[mt][nt][r]);
          }
        __syncthreads();
#pragma unroll
        for (int i = 0; i < 16; ++i) {
          const int id = tid + 256 * i, col = id >> 5, q = id & 31;
          const uint4 v = *(const uint4*)(T + col * 264 + q * 8);
          const int rho0 = q * 8;
          const int r_ = rho0 >> (8 - sh), j0 = rho0 & ((256 >> sh) - 1);
          const int pos = (r_ << (13 - sh)) + (s0 >> sh) + j0;
          const int head = ((nt_ & 3) << 1) + (col >> 6), d = col & 63;
          const size_t hb = (size_t)((bq * 3 + g) * 8 + head);
          *(uint4*)(p.Vt() + (hb * 64 + d) * 8192 + pos) = v;
        }
      }
    } else {
      u16* dst; int ldd; bool act;
      if (nt_ < 40) { dst = out16 + 16777216 + (nt_ - 36) * 128; ldd = 1024; act = true; }
      else if (nt_ < 52) { dst = p.Pg() + (nt_ - 40) * 128; ldd = 1536; act = false; }
      else { dst = out16 + 16777216 + 512 + (nt_ - 52) * 128; ldd = 1024; act = true; }
#pragma unroll
      for (int mt = 0; mt < 8; ++mt)
#pragma unroll
        for (int r = 0; r < 4; ++r) {
          const int lrow = wr * 128 + mt * 16 + kq * 4 + r;
          float v4[4];
#pragma unroll
          for (int nt = 0; nt < 4; ++nt) { float v = acc[mt][nt][r]; if (act) v = silu(v); v4[nt] = v; }
          stage4(T + lrow * 136 + wc * 64 + l15, v4[0], v4[1], v4[2], v4[3]);
        }
      __syncthreads();
#pragma unroll
      for (int i = 0; i < 16; ++i) {
        const int id = tid + 256 * i, lrow = id >> 4, pc = id & 15;
        const uint4 v = *(const uint4*)(T + lrow * 136 + pc * 8);
        *(uint4*)(dst + (size_t)(row0 + lrow) * ldd + pc * 8) = v;
      }
    }
    __syncthreads();
  }
}

DEVFN void phase_attn(const Params& p, char* smem) {
  const int tid = get_tid(), lane = tid & 63, wave = tid >> 6;
  const int kq = lane >> 4, l15 = lane & 15;
  u16* Ks = (u16*)smem;
  u16* Vs = Ks + 256 * 72;
  uint4 kr_0, kr_1, kr_2, kr_3, kr_4, kr_5, kr_6, kr_7, vr_0, vr_1, vr_2, vr_3, vr_4, vr_5, vr_6, vr_7;
  bf16x8 qn_00, qn_01, qn_10, qn_11;
#define ATT_LDK(i) kr_##i = *(const uint4*)(kp_ + 32 * i * 64);
#define ATT_LDV(i) vr_##i = *(const uint4*)(vp_ + (long)(8 * i) * 8192);
#define ATT_LOADKQ(it)                                                                                 \
  {                                                                                                     \
    const int kb_ = (it) & 63, base_ = (it) >> 6, p0_ = kb_ * 128;                                      \
    const u16* kp_ = p.Kp() + (((long)base_ * 8192 + p0_ - 128) * 64 + (tid >> 3) * 64 + (tid & 7) * 8); \
    ATT_LDK(0) ATT_LDK(1) ATT_LDK(2) ATT_LDK(3) ATT_LDK(4) ATT_LDK(5) ATT_LDK(6) ATT_LDK(7)             \
    const u16* Qn_ = p.Qp() + ((size_t)base_ * 8192 + p0_ + 32 * wave) * 64 + l15 * 64 + kq * 8;        \
    qn_00 = *(const bf16x8*)(Qn_); qn_01 = *(const bf16x8*)(Qn_ + 32);                                  \
    qn_10 = *(const bf16x8*)(Qn_ + 1024); qn_11 = *(const bf16x8*)(Qn_ + 1024 + 32);                    \
  }
#define ATT_LOADV(it)                                                                                  \
  {                                                                                                     \
    const int kb_ = (it) & 63, base_ = (it) >> 6, p0_ = kb_ * 128;                                      \
    const u16* vp_ = p.Vt() + ((long)base_ * 64 * 8192 + p0_ - 128 + (long)(tid >> 5) * 8192 + (tid & 31) * 8); \
    ATT_LDV(0) ATT_LDV(1) ATT_LDV(2) ATT_LDV(3) ATT_LDV(4) ATT_LDV(5) ATT_LDV(6) ATT_LDV(7)             \
  }
#define ATT_STK(i) *(uint4*)(Ks + ((tid >> 3) + 32 * i) * 72 + (tid & 7) * 8) = kr_##i;
#define ATT_STV(i) *(uint4*)(Vs + ((tid >> 5) + 8 * i) * 264 + (tid & 31) * 8) = vr_##i;
  ATT_LOADKQ(blockIdx.x < 3072 ? (int)blockIdx.x : 0)
  for (int item = blockIdx.x; item < 3072; item += gridDim.x) {
    const int kb = item & 63, base = item >> 6;
    const int h = base & 7, bg_ = base >> 3, g = bg_ % 3, b = bg_ / 3;
    const int sh = 2 * g, sublen = 8192 >> sh;
    const int p0 = kb * 128;
    const bool first = ((p0 & (sublen - 1)) == 0);
    ATT_STK(0) ATT_STK(1) ATT_STK(2) ATT_STK(3) ATT_STK(4) ATT_STK(5) ATT_STK(6) ATT_STK(7)
    bf16x8 qf[2][2];
    qf[0][0] = qn_00; qf[0][1] = qn_01; qf[1][0] = qn_10; qf[1][1] = qn_11;
    __syncthreads();
    u16* Qg = p.Qp() + ((size_t)base * 8192 + p0 + 32 * wave) * 64;
    ATT_LOADV(item)
    {
      const int nxt = item + gridDim.x;
      const int itl = nxt < 3072 ? nxt : item;
      ATT_LOADKQ(itl)
    }
    __builtin_amdgcn_sched_barrier(0);
    f32x4 st[10][2];
#pragma unroll
    for (int mt = 0; mt < 10; ++mt) {
      const u16* kr = Ks + (32 * wave + mt * 16 + l15) * 72 + kq * 8;
      const bf16x8 k0 = *(const bf16x8*)kr, k1 = *(const bf16x8*)(kr + 32);
#pragma unroll
      for (int nt = 0; nt < 2; ++nt) {
        f32x4 c = f32x4{0.f, 0.f, 0.f, 0.f};
        if (mt - nt >= 0 && mt - nt <= 8) {
          c = MFMA16(k0, qf[nt][0], c);
          c = MFMA16(k1, qf[nt][1], c);
        }
        st[mt][nt] = c;
      }
    }
    float mx[2] = {-1e30f, -1e30f};
#pragma unroll
    for (int mt = 0; mt < 10; ++mt)
#pragma unroll
      for (int nt = 0; nt < 2; ++nt) {
        const int dd = mt - nt;
#pragma unroll
        for (int r = 0; r < 4; ++r) {
          float s = st[mt][nt][r];
          if (dd < 0 || dd > 8) s = -1e30f;
          else if (dd == 0) { if (kq * 4 + r - l15 < 0) s = -1e30f; }
          else if (dd == 8) { if (kq * 4 + r - l15 > 0) s = -1e30f; }
          st[mt][nt][r] = s;
        }
      }
    if (first) {
#pragma unroll
      for (int mt = 0; mt < 10; ++mt)
#pragma unroll
        for (int nt = 0; nt < 2; ++nt)
#pragma unroll
          for (int r = 0; r < 4; ++r)
            if (32 * wave + mt * 16 + kq * 4 + r < 128) st[mt][nt][r] = -1e30f;
    }
#pragma unroll
    for (int mt = 0; mt < 10; ++mt)
#pragma unroll
      for (int nt = 0; nt < 2; ++nt)
#pragma unroll
        for (int r = 0; r < 4; ++r) mx[nt] = fmaxf(mx[nt], st[mt][nt][r]);
    float sum[2] = {0.f, 0.f};
#pragma unroll
    for (int nt = 0; nt < 2; ++nt) {
      mx[nt] = fmaxf(mx[nt], __shfl_xor(mx[nt], 16));
      mx[nt] = fmaxf(mx[nt], __shfl_xor(mx[nt], 32));
    }
#pragma unroll
    for (int mt = 0; mt < 10; ++mt)
#pragma unroll
      for (int nt = 0; nt < 2; ++nt)
#pragma unroll
        for (int r = 0; r < 4; ++r) {
          const float e = __builtin_amdgcn_exp2f(st[mt][nt][r] - mx[nt]);
          st[mt][nt][r] = e;
          sum[nt] += e;
        }
#pragma unroll
    for (int nt = 0; nt < 2; ++nt) {
      sum[nt] += __shfl_xor(sum[nt], 16);
      sum[nt] += __shfl_xor(sum[nt], 32);
    }
    ATT_STV(0) ATT_STV(1) ATT_STV(2) ATT_STV(3) ATT_STV(4) ATT_STV(5) ATT_STV(6) ATT_STV(7)
    __syncthreads();
    f32x4 ot[4][2];
#pragma unroll
    for (int dt = 0; dt < 4; ++dt)
#pragma unroll
      for (int nt = 0; nt < 2; ++nt) ot[dt][nt] = f32x4{0.f, 0.f, 0.f, 0.f};
#pragma unroll
    for (int t = 0; t < 5; ++t) {
      bf16x8 pf[2];
#pragma unroll
      for (int nt = 0; nt < 2; ++nt) pf[nt] = pack8(st[2 * t][nt], st[2 * t + 1][nt]);
#pragma unroll
      for (int dt = 0; dt < 4; ++dt) {
        const u16* vr = Vs + (dt * 16 + l15) * 264 + 32 * wave + 32 * t + kq * 4;
        BF8 vf;
        const uint2 lo = *(const uint2*)vr, hi = *(const uint2*)(vr + 16);
        vf.u[0] = lo.x; vf.u[1] = lo.y; vf.u[2] = hi.x; vf.u[3] = hi.y;
#pragma unroll
        for (int nt = 0; nt < 2; ++nt) ot[dt][nt] = MFMA16(vf.v, pf[nt], ot[dt][nt]);
      }
    }
#pragma unroll
    for (int nt = 0; nt < 2; ++nt) {
      const float inv = 1.f / sum[nt];
#pragma unroll
      for (int dt = 0; dt < 4; ++dt) {
        uint2 pk;
        pk.x = pack2(ot[dt][nt][0] * inv, ot[dt][nt][1] * inv);
        pk.y = pack2(ot[dt][nt][2] * inv, ot[dt][nt][3] * inv);
        *(uint2*)(Qg + (nt * 16 + l15) * 64 + dt * 16 + kq * 4) = pk;
      }
      if (kq == 0) {
        const int pos = p0 + 32 * wave + nt * 16 + l15;
        const int r_ = pos >> (13 - sh), i_ = pos & (sublen - 1);
        const int s = (i_ << sh) + r_;
        p.lse()[((size_t)(b * 8192 + s)) * 24 + g * 8 + h] = (mx[nt] + log2f(sum[nt])) * 0.6931471805599453f;
      }
    }
  }
  __syncthreads();
}


DEVFN bf16x8 ld8_bf(const float* p) {
  const float4 a = *(const float4*)p, b = *(const float4*)(p + 4);
  BF8 r;
  r.u[0] = pack2(a.x, a.y); r.u[1] = pack2(a.z, a.w); r.u[2] = pack2(b.x, b.y); r.u[3] = pack2(b.z, b.w);
  return r.v;
}
DEVFN void ld8_bf_split(const float* p, bf16x8& hi, bf16x8& lo) {
  const float4 a = *(const float4*)p, b = *(const float4*)(p + 4);
  const float v[8] = {a.x, a.y, a.z, a.w, b.x, b.y, b.z, b.w};
  BF8 h, l;
#pragma unroll
  for (int e = 0; e < 4; ++e) {
    h.u[e] = pack2(v[2 * e], v[2 * e + 1]);
    const float r0 = v[2 * e] - __uint_as_float(h.u[e] << 16), r1 = v[2 * e + 1] - __uint_as_float(h.u[e] & 0xffff0000u);
    l.u[e] = pack2(r0, r1);
  }
  hi = h.v; lo = l.v;
}

template <int J, int I4> struct SolveInner {
  static DEVFN void run(float (&X)[64], const float* amT, float xj) {
    if (I4 + 3 > J) {
      const float4 a = *(const float4*)(amT + J * 68 + I4);
      if (I4 + 0 > J) X[I4 + 0] -= a.x * xj;
      if (I4 + 1 > J) X[I4 + 1] -= a.y * xj;
      if (I4 + 2 > J) X[I4 + 2] -= a.z * xj;
      if (I4 + 3 > J) X[I4 + 3] -= a.w * xj;
    }
    SolveInner<J, I4 + 4>::run(X, amT, xj);
  }
};
template <int J> struct SolveInner<J, 64> { static DEVFN void run(float (&)[64], const float*, float) {} };
template <int J> struct SolveOuter {
  static DEVFN void run(float (&X)[64], const float* amT) {
    SolveInner<J, ((J + 1) / 4) * 4>::run(X, amT, X[J]);
    if ((J & 3) == 3) __builtin_amdgcn_sched_barrier(0);
    SolveOuter<J + 1>::run(X, amT);
  }
};
template <> struct SolveOuter<63> { static DEVFN void run(float (&)[64], const float*) {} };

DEVFN void phase_chunk(const Params& p, char* smem) {
  float* qs = (float*)smem;
  float* ks = qs + 64 * 68;
  float* vs = ks + 64 * 68;
  float* amT = vs + 64 * 68;
  float* Gs = amT + 64 * 68;
  float* bs = Gs + 64;
  float* eG = bs + 64;
  float* eK = eG + 64;
  float* cwl = eK + 64;
  const bool one_bh = (gridDim.x == 512);
  if (one_bh) {
    const int h0 = blockIdx.x & 7;
    for (int idx = threadIdx.x; idx < 768; idx += NT) {
      const int sel = idx >> 8, j = (idx >> 6) & 3, d = idx & 63;
      cwl[idx] = p.conv_w[j * 1536 + sel * 512 + h0 * 64 + d];
    }
    __syncthreads();
  }
  for (int cit = blockIdx.x; cit < 2048; cit += gridDim.x) {
    int tid = threadIdx.x;
    asm volatile("" : "+v"(tid));
    const int lane = tid & 63, wave = __builtin_amdgcn_readfirstlane(tid >> 6);
    const int kq = lane >> 4, l15 = lane & 15;
    const int ci = one_bh ? ((int)(blockIdx.x & 15) * 128 + (int)(blockIdx.x >> 4) + 32 * (cit >> 9)) : cit;
    const int n = ci & 127, bh = ci >> 7, h = bh & 7, b = bh >> 3;
    const int row0 = b * 8192 + n * 64;
    u16* cb = p.chunk() + (size_t)ci * 24576;
    const float gg0 = p.bg()[(size_t)(row0 + lane) * 16 + 8 + h];
    const float be0 = p.bg()[(size_t)(row0 + lane) * 16 + h];
    {
      const int t = tid >> 2, part = tid & 3;
      BF8 raw[3][4][2];
      float msk[4];
#pragma unroll
      for (int j = 0; j < 4; ++j) {
        const int tok = n * 64 + t - 3 + j;
        msk[j] = tok >= 0 ? 1.f : 0.f;
        const int tokc = tok >= 0 ? tok : 0;
        const u16* src = p.Pg() + (size_t)(b * 8192 + tokc) * 1536 + h * 64 + part * 16;
#pragma unroll
        for (int sel = 0; sel < 3; ++sel) {
          raw[sel][j][0].q = *(const uint4*)(src + sel * 512);
          raw[sel][j][1].q = *(const uint4*)(src + sel * 512 + 8);
        }
      }
#pragma unroll
      for (int sel = 0; sel < 3; ++sel) {
        const int ch = sel * 512 + h * 64 + part * 16;
        float a[16];
#pragma unroll
        for (int d = 0; d < 16; ++d) a[d] = 0.f;
#pragma unroll
        for (int j = 0; j < 4; ++j) {
          const BF8& r0 = raw[sel][j][0];
          const BF8& r1 = raw[sel][j][1];
          const float* cwg = p.conv_w + j * 1536 + ch;
          const float* cws = cwl + (sel * 4 + j) * 64 + part * 16;
#pragma unroll
          for (int d = 0; d < 4; ++d) {
            float4 w4;
            if (one_bh) w4 = *(const float4*)(cws + 4 * d); else w4 = *(const float4*)(cwg + 4 * d);
            const float mj = msk[j];
            const unsigned ua = d < 2 ? r0.u[2 * d] : r1.u[2 * d - 4];
            const unsigned ub = d < 2 ? r0.u[2 * d + 1] : r1.u[2 * d - 3];
            a[4 * d + 0] += (w4.x * mj) * __uint_as_float(ua << 16);
            a[4 * d + 1] += (w4.y * mj) * __uint_as_float(ua & 0xffff0000u);
            a[4 * d + 2] += (w4.z * mj) * __uint_as_float(ub << 16);
            a[4 * d + 3] += (w4.w * mj) * __uint_as_float(ub & 0xffff0000u);
          }
        }
        float ss = 0.f;
#pragma unroll
        for (int d = 0; d < 16; ++d) { a[d] = silu(a[d]); ss += a[d] * a[d]; }
        float sc = 1.f;
        if (sel < 2) {
          ss += __shfl_xor(ss, 1);
          ss += __shfl_xor(ss, 2);
          sc = rsqrtf(ss + EPS) * (sel == 0 ? 0.125f : 1.f);
        }
        float* dst = (sel == 0 ? qs : (sel == 1 ? ks : vs)) + t * 68 + part * 16;
#pragma unroll
        for (int d = 0; d < 4; ++d) *(float4*)(dst + 4 * d) = make_float4(a[4 * d] * sc, a[4 * d + 1] * sc, a[4 * d + 2] * sc, a[4 * d + 3] * sc);
      }
    }
    if (wave == 0) {
      float gg = gg0;
#pragma unroll
      for (int o = 1; o < 64; o <<= 1) { const float v = __shfl_up(gg, o); if (lane >= o) gg += v; }
      const float gl = __shfl(gg, 63);
      Gs[lane] = gg;
      bs[lane] = be0;
      eG[lane] = __expf(gg);
      eK[lane] = __expf(gl - gg);
    }
    __syncthreads();
    {
      bf16x8 akh[2], akl[2], aqf[2];
#pragma unroll
      for (int t = 0; t < 2; ++t) {
        ld8_bf_split(ks + (16 * wave + l15) * 68 + 32 * t + kq * 8, akh[t], akl[t]);
        aqf[t] = ld8_bf(qs + (16 * wave + l15) * 68 + 32 * t + kq * 8);
      }
      u16* At = cb + 8192;
      for (int jt = 0; jt < 4; ++jt) {
        if (jt <= wave) {
          f32x4 cK = f32x4{0.f, 0.f, 0.f, 0.f}, cQ = f32x4{0.f, 0.f, 0.f, 0.f};
#pragma unroll
          for (int t = 0; t < 2; ++t) {
            bf16x8 bh, bl;
            ld8_bf_split(ks + (16 * jt + l15) * 68 + 32 * t + kq * 8, bh, bl);
            cK = MFMA16(akl[t], bh, cK);
            cK = MFMA16(akh[t], bl, cK);
            cK = MFMA16(akh[t], bh, cK);
            cQ = MFMA16(aqf[t], bh, cQ);
          }
          const int j = 16 * jt + l15;
          const float Gj = Gs[j];
          float av[4];
#pragma unroll
          for (int r = 0; r < 4; ++r) {
            const int i = 16 * wave + kq * 4 + r;
            const float e = (j <= i) ? __expf(Gs[i] - Gj) : 0.f;
            av[r] = (j < i) ? bs[i] * cK[r] * e : 0.f;
            At[i * 64 + permk(j)] = f2bf(cQ[r] * e);
          }
          *(float4*)(amT + j * 68 + 16 * wave + kq * 4) = make_float4(av[0], av[1], av[2], av[3]);
        } else {
          const int j = 16 * jt + l15;
#pragma unroll
          for (int r = 0; r < 4; ++r) At[(16 * wave + kq * 4 + r) * 64 + permk(j)] = 0;
        }
      }
    }
    __syncthreads();
    float X[64];
    if (tid < 64) {
#pragma unroll
      for (int i = 0; i < 64; ++i) X[i] = vs[i * 68 + tid] * bs[i];
    } else if (tid < 128) {
#pragma unroll
      for (int i = 0; i < 64; ++i) X[i] = ks[i * 68 + tid - 64] * bs[i] * eG[i];
    } else {
      const int tt = tid - 128;
      u16* Qd = cb + 4096;
      for (int idx = tt; idx < 4096; idx += 128) {
        const int c = idx >> 6, dk = idx & 63;
        Qd[c * 64 + permk(dk)] = f2bf(qs[c * 68 + dk] * eG[c]);
      }
    }
    __syncthreads();
    if (tid < 128) {
      SolveOuter<0>::run(X, amT);
      if (tid < 64) {
        const int v = tid;
        u16* U = cb + 12288;
#pragma unroll
        for (int i = 0; i < 64; ++i) {
          vs[i * 68 + v] = X[i];
          const int mt = i >> 4, kq2 = (i >> 2) & 3, r = i & 3;
          U[((v >> 4) * 64 + kq2 * 16 + (v & 15)) * 16 + mt * 4 + r] = f2bf(X[i]);
        }
      } else {
        const int dk = tid - 64;
        u16* W = cb;
        const int pk = permk(dk);
#pragma unroll
        for (int i = 0; i < 64; ++i) {
          qs[i * 68 + dk] = X[i];
          W[i * 64 + pk] = f2bf(X[i]);
        }
      }
    }
    __syncthreads();
    {
      const float dec = eG[63];
      bf16x8 akd[2];
#pragma unroll
      for (int t = 0; t < 2; ++t) {
        float v[8];
#pragma unroll
        for (int j = 0; j < 8; ++j) {
          const int c = 32 * t + kq * 8 + j;
          v[j] = ks[c * 68 + 16 * wave + l15] * eK[c];
        }
        BF8 r;
#pragma unroll
        for (int e = 0; e < 4; ++e) r.u[e] = pack2(v[2 * e], v[2 * e + 1]);
        akd[t] = r.v;
      }
      u16* Mo = cb + 16384;
      u16* Bo = cb + 20480;
#pragma unroll
      for (int jt = 0; jt < 4; ++jt) {
        f32x4 cM = f32x4{0.f, 0.f, 0.f, 0.f}, cB = f32x4{0.f, 0.f, 0.f, 0.f};
#pragma unroll
        for (int t = 0; t < 2; ++t) {
          BF8 bw, bu;
#pragma unroll
          for (int e = 0; e < 4; ++e) {
            const int c = 32 * t + kq * 8 + 2 * e;
            bw.u[e] = pack2(qs[c * 68 + 16 * jt + l15], qs[(c + 1) * 68 + 16 * jt + l15]);
            bu.u[e] = pack2(vs[c * 68 + 16 * jt + l15], vs[(c + 1) * 68 + 16 * jt + l15]);
          }
          cM = MFMA16(akd[t], bw.v, cM);
          cB = MFMA16(akd[t], bu.v, cB);
        }
        const int col = 16 * jt + l15;
        const int pc = permk(col);
#pragma unroll
        for (int r = 0; r < 4; ++r) {
          const int dkp = 16 * wave + kq * 4 + r;
          const float m = (dkp == col ? dec : 0.f) - cM[r];
          Mo[dkp * 64 + pc] = f2bf(m);
        }
        uint2 pk;
        pk.x = pack2(cB[0], cB[1]); pk.y = pack2(cB[2], cB[3]);
        *(uint2*)(Bo + (jt * 64 + lane) * 16 + wave * 4) = pk;
      }
    }
    __syncthreads();
  }
}

#define GREC_OFF 246415360ull
#define GHALF_OFF 250609664ull

#define SC_LOAD(st, rec, Moff, Boff)                                                        \
  {                                                                                          \
    const u16* cbn_ = (rec);                                                                 \
    _Pragma("unroll") for (int mt = 0; mt < 4; ++mt) {                                       \
      Mf[st][mt * 2 + 0] = *(const bf16x8*)(cbn_ + (Moff) + (mt * 16 + l15) * 64 + kq * 8);  \
      Mf[st][mt * 2 + 1] = *(const bf16x8*)(cbn_ + (Moff) + (mt * 16 + l15) * 64 + 32 + kq * 8); \
    }                                                                                        \
    Bq[st][0].q = *(const uint4*)(cbn_ + (Boff) + (vsl * 64 + lane) * 16);                   \
    Bq[st][1].q = *(const uint4*)(cbn_ + (Boff) + (vsl * 64 + lane) * 16 + 8);               \
  }

DEVFN f32x4 unpack_c(const BF8 (&Bq)[2], int mt) {
  const unsigned u0 = Bq[mt >> 1].u[(mt & 1) * 2], u1 = Bq[mt >> 1].u[(mt & 1) * 2 + 1];
  f32x4 c;
  c[0] = __uint_as_float(u0 << 16); c[1] = __uint_as_float(u0 & 0xffff0000u);
  c[2] = __uint_as_float(u1 << 16); c[3] = __uint_as_float(u1 & 0xffff0000u);
  return c;
}

template <int NS, bool STORE = true>
DEVFN void scan_steps(const u16* rec0, size_t rstride, int Moff, int Boff, bf16x8 (&Sb)[2], u16* sd0, size_t sstride,
                      int vsl, int lane) {
  const int kq = lane >> 4, l15 = lane & 15;
  bf16x8 Mf[4][8];
  BF8 Bq[4][2];
#pragma unroll
  for (int i = 0; i < 4 && i < NS; ++i) SC_LOAD(i, rec0 + (size_t)i * rstride, Moff, Boff)
#pragma unroll
  for (int i = 0; i < NS; ++i) {
    const int st = i & 3;
    f32x4 acc[4];
#pragma unroll
    for (int mt = 0; mt < 4; ++mt) {
      f32x4 c = unpack_c(Bq[st], mt);
      c = MFMA16(Mf[st][mt * 2 + 0], Sb[0], c);
      c = MFMA16(Mf[st][mt * 2 + 1], Sb[1], c);
      acc[mt] = c;
    }
    Sb[0] = pack8(acc[0], acc[1]);
    Sb[1] = pack8(acc[2], acc[3]);
    if (STORE) {
      u16* sd = sd0 + (size_t)i * sstride;
      *(bf16x8*)(sd) = Sb[0];
      *(bf16x8*)(sd + 512) = Sb[1];
    }
    if (i + 4 < NS) SC_LOAD(st, rec0 + (size_t)(i + 4) * rstride, Moff, Boff)
  }
}

typedef unsigned __attribute__((ext_vector_type(4))) u32x4s;
DEVFN void merge_tokens(const Params& p, int wid, int nw, int tk0, int tk1, int lane);
DEVFN void phase_scan_x1(const Params& p, char* smem) {
  const int tid = get_tid(), lane = tid & 63, wave = tid >> 6;
  if (gridDim.x == 512 && blockIdx.x >= 256) {
    merge_tokens(p, (blockIdx.x - 256) * 4 + wave, 1024, 0, 8192, lane);
    return;
  }
  const int kq = lane >> 4, l15 = lane & 15;
  const int vsl = wave;
  u16* grec = (u16*)(p.ws + GREC_OFF);
  for (int task = blockIdx.x; task < 256; task += gridDim.x) {
    const int bh = task >> 4, g = task & 15;
    const u16* rec0 = p.chunk() + (size_t)(bh * 128 + g * 8) * 24576;
    bf16x8 Mb[2], Bb[2];
    {
      BF8 m0, m1, z;
      z.q = make_uint4(0, 0, 0, 0);
      m0.q = z.q; m1.q = z.q;
      const int colr = vsl * 16 + l15;
#pragma unroll
      for (int j = 0; j < 8; ++j) {
        const int dk0 = (j >> 2) * 16 + kq * 4 + (j & 3);
        const unsigned one = 0x3f80u << ((j & 1) * 16);
        if (dk0 == colr) m0.u[j >> 1] |= one;
        if (dk0 + 32 == colr) m1.u[j >> 1] |= one;
      }
      Mb[0] = m0.v; Mb[1] = m1.v; Bb[0] = z.v; Bb[1] = z.v;
    }
    f32x4 aM[4], aB[4];
    u16* lbuf = (u16*)smem;
    const int row_w = tid >> 3, ch_w = tid & 7;
    const int woff = row_w * 64 + ((ch_w ^ ((row_w >> 1) & 7)) << 3);
    u32x4s rm[8][2];
    BF8 rb[8][2];
#pragma unroll
    for (int r = 0; r < 8; ++r) {
      const u16* rec_ = rec0 + (size_t)r * 24576;
      rm[r][0] = *(const u32x4s*)(rec_ + 16384 + tid * 8);
      rm[r][1] = *(const u32x4s*)(rec_ + 16384 + (tid + 256) * 8);
      rb[r][0].q = *(const uint4*)(rec_ + 20480 + (vsl * 64 + lane) * 16);
      rb[r][1].q = *(const uint4*)(rec_ + 20480 + (vsl * 64 + lane) * 16 + 8);
    }
#pragma unroll
    for (int i = 0; i < 8; ++i) {
      u16* lb = lbuf + (i & 1) * 4096;
      *(u32x4s*)(lb + woff) = rm[i][0];
      *(u32x4s*)(lb + woff + 32 * 64) = rm[i][1];
      __syncthreads();
#pragma unroll
      for (int mt = 0; mt < 4; ++mt) {
        const u16* fr = lb + (mt * 16 + l15) * 64;
        const bf16x8 m0 = *(const bf16x8*)(fr + (((0 + kq) ^ ((l15 >> 1) & 7)) << 3));
        const bf16x8 m1 = *(const bf16x8*)(fr + (((4 + kq) ^ ((l15 >> 1) & 7)) << 3));
        f32x4 c = f32x4{0.f, 0.f, 0.f, 0.f};
        c = MFMA16(m0, Mb[0], c);
        c = MFMA16(m1, Mb[1], c);
        aM[mt] = c;
        f32x4 d = unpack_c(rb[i], mt);
        d = MFMA16(m0, Bb[0], d);
        d = MFMA16(m1, Bb[1], d);
        aB[mt] = d;
      }
      Mb[0] = pack8(aM[0], aM[1]); Mb[1] = pack8(aM[2], aM[3]);
      Bb[0] = pack8(aB[0], aB[1]); Bb[1] = pack8(aB[2], aB[3]);
      if (i == 3) {
        u16* gh = (u16*)(p.ws + GHALF_OFF) + (size_t)task * 8192;
        const int pch = permk(vsl * 16 + l15);
#pragma unroll
        for (int mt = 0; mt < 4; ++mt) {
#pragma unroll
          for (int r = 0; r < 4; ++r) gh[(mt * 16 + kq * 4 + r) * 64 + pch] = f2bf(aM[mt][r]);
          uint2 pk;
          pk.x = pack2(aB[mt][0], aB[mt][1]); pk.y = pack2(aB[mt][2], aB[mt][3]);
          *(uint2*)(gh + 4096 + (vsl * 64 + lane) * 16 + mt * 4) = pk;
        }
      }
    }
    u16* gr = grec + (size_t)task * 8192;
    const int pc = permk(vsl * 16 + l15);
#pragma unroll
    for (int mt = 0; mt < 4; ++mt) {
#pragma unroll
      for (int r = 0; r < 4; ++r) gr[(mt * 16 + kq * 4 + r) * 64 + pc] = f2bf(aM[mt][r]);
      uint2 pk;
      pk.x = pack2(aB[mt][0], aB[mt][1]); pk.y = pack2(aB[mt][2], aB[mt][3]);
      *(uint2*)(gr + 4096 + (vsl * 64 + lane) * 16 + mt * 4) = pk;
    }
  }
}

DEVFN void merge_tokens(const Params& p, int wid, int nw, int tk0, int tk1, int lane) {
  u16* out16 = (u16*)p.out;
  for (int tk = tk0 + wid; tk < tk1; tk += nw) {
      const int b = tk >> 13, s = tk & 8191;
      const int hh = lane >> 3, d8 = (lane & 7) * 8;
      float l[3];
      BF8 og[3];
#pragma unroll
      for (int g = 0; g < 3; ++g) {
        const int sh = 2 * g;
        const int pos = ((s & ((1 << sh) - 1)) << (13 - sh)) + (s >> sh);
        og[g].q = *(const uint4*)(p.Qp() + ((size_t)((b * 3 + g) * 8 + hh) * 8192 + pos) * 64 + d8);
        l[g] = p.lse()[(size_t)tk * 24 + g * 8 + hh];
      }
      const float ml = fmaxf(l[0], fmaxf(l[1], l[2]));
      float w[3];
      float den = 0.f;
#pragma unroll
      for (int g = 0; g < 3; ++g) { w[g] = __expf(l[g] - ml); den += w[g]; }
      const float inv = 1.f / den;
      u16* zp = out16 + 16777216 + (size_t)tk * 1024 + hh * 64 + d8;
      BF8 z; z.q = *(const uint4*)zp;
      BF8 res;
#pragma unroll
      for (int i = 0; i < 4; ++i) {
        float o0 = 0.f, o1 = 0.f;
#pragma unroll
        for (int g = 0; g < 3; ++g) {
          o0 += w[g] * __uint_as_float(og[g].u[i] << 16);
          o1 += w[g] * __uint_as_float(og[g].u[i] & 0xffff0000u);
        }
        o0 *= inv * __uint_as_float(z.u[i] << 16);
        o1 *= inv * __uint_as_float(z.u[i] & 0xffff0000u);
        res.u[i] = pack2(o0, o1);
      }
      *(uint4*)zp = res.q;
    }
}

DEVFN void late_transposes(const Params& p, char* smem, int bm, int nbm) {
  float* ts = (float*)smem;
  for (int t = bm; t < 1024; t += nbm) {
    if (t < 512) {
      const int n0 = (112 + (t >> 4)) * 64, k0 = (t & 15) * 64;
      transpose_tile(p.w_in, NWIN, 1024, p.WtIn(), k0, n0, n0 + 16, ts);
    } else if (t < 640) {
      const int u = t - 512, n0 = (u >> 3) * 64, k0 = (u & 7) * 64;
      transpose_tile(p.w_up_a, 1024, 512, p.WtUpA(), k0, n0, n0, ts);
    } else if (t < 768) {
      const int u = t - 640, n0 = (u >> 3) * 64, k0 = (u & 7) * 64;
      transpose_tile(p.w_up_b, 1024, 512, p.WtUpB(), k0, n0, n0, ts);
    } else {
      const int u = t - 768, n0 = (u >> 4) * 64, k0 = (u & 15) * 64;
      transpose_tile(p.w_out, 1024, 1024, p.WtOut(), k0, n0, n0, ts);
    }
  }
}

DEVFN void phase_scan_merge(const Params& p, char* smem) {
  const int tid = get_tid(), lane = tid & 63, wave = tid >> 6;
  if (blockIdx.x < 16) {
    const int ci0 = blockIdx.x * 128;
    const int vsl = wave;
    bf16x8 Sb[2];
    {
      BF8 z; z.q = make_uint4(0, 0, 0, 0);
      Sb[0] = z.v; Sb[1] = z.v;
    }
    u16* sdst = p.Sbuf() + ((size_t)ci0 * 4 + vsl) * 1024 + lane * 8;
    *(bf16x8*)(sdst) = Sb[0];
    *(bf16x8*)(sdst + 512) = Sb[1];
    const u16* grec = (const u16*)(p.ws + GREC_OFF) + (size_t)blockIdx.x * 16 * 8192;
    {
      const int kq = lane >> 4, l15 = lane & 15;
      u16* lbuf = (u16*)smem;
      const int row_w = tid >> 3, ch_w = tid & 7;
      const int woff = row_w * 64 + ((ch_w ^ ((row_w >> 1) & 7)) << 3);
      u32x4s rm[8][2];
      BF8 rb[8][2];
#define X2_LOAD(slot, g)                                                                     \
      {                                                                                      \
        const u16* rec_ = grec + (size_t)(g) * 8192;                                         \
        rm[slot][0] = *(const u32x4s*)(rec_ + tid * 8);                                      \
        rm[slot][1] = *(const u32x4s*)(rec_ + (tid + 256) * 8);                              \
        rb[slot][0].q = *(const uint4*)(rec_ + 4096 + (vsl * 64 + lane) * 16);               \
        rb[slot][1].q = *(const uint4*)(rec_ + 4096 + (vsl * 64 + lane) * 16 + 8);           \
      }
#pragma unroll
      for (int r = 0; r < 8; ++r) X2_LOAD(r, r)
#pragma unroll
      for (int i = 0; i < 15; ++i) {
        const int sl = i & 7;
        u16* lb = lbuf + (i & 1) * 4096;
        *(u32x4s*)(lb + woff) = rm[sl][0];
        *(u32x4s*)(lb + woff + 32 * 64) = rm[sl][1];
        __syncthreads();
        const BF8 b0 = rb[sl][0], b1 = rb[sl][1];
        if (i + 8 < 15) X2_LOAD(sl, i + 8)
        f32x4 acc[4];
#pragma unroll
        for (int mt = 0; mt < 4; ++mt) {
          const u16* fr = lb + (mt * 16 + l15) * 64;
          const bf16x8 m0 = *(const bf16x8*)(fr + (((0 + kq) ^ ((l15 >> 1) & 7)) << 3));
          const bf16x8 m1 = *(const bf16x8*)(fr + (((4 + kq) ^ ((l15 >> 1) & 7)) << 3));
          const BF8& bb = (mt >> 1) ? b1 : b0;
          const unsigned u0 = bb.u[(mt & 1) * 2], u1 = bb.u[(mt & 1) * 2 + 1];
          f32x4 c;
          c[0] = __uint_as_float(u0 << 16); c[1] = __uint_as_float(u0 & 0xffff0000u);
          c[2] = __uint_as_float(u1 << 16); c[3] = __uint_as_float(u1 & 0xffff0000u);
          c = MFMA16(m0, Sb[0], c);
          c = MFMA16(m1, Sb[1], c);
          acc[mt] = c;
        }
        Sb[0] = pack8(acc[0], acc[1]);
        Sb[1] = pack8(acc[2], acc[3]);
        u16* sd = sdst + (size_t)(i + 1) * 8 * 4096;
        *(bf16x8*)(sd) = Sb[0];
        *(bf16x8*)(sd + 512) = Sb[1];
      }
#undef X2_LOAD
    }
  } else {
    late_transposes(p, smem, blockIdx.x - 16, gridDim.x - 16);
    if (gridDim.x == 512) merge_tokens(p, (blockIdx.x - 16) * 4 + wave, (gridDim.x - 16) * 4, 8192, 16384, lane);
    else merge_tokens(p, (blockIdx.x - 16) * 4 + wave, (gridDim.x - 16) * 4, 0, 16384, lane);
  }
}

DEVFN void phase_scan_x3(const Params& p) {
  const int tid = get_tid(), lane = tid & 63, wave = tid >> 6;
  const int vsl = wave;
  for (int task = blockIdx.x; task < 256; task += gridDim.x) {
    const int bh = task >> 4, g = task & 15;
    const int c0 = bh * 128 + g * 8;
    u16* sp = p.Sbuf() + ((size_t)c0 * 4 + vsl) * 1024 + lane * 8;
    bf16x8 Sb[2];
    Sb[0] = *(const bf16x8*)sp;
    Sb[1] = *(const bf16x8*)(sp + 512);
    scan_steps<7>(p.chunk() + (size_t)c0 * 24576, 24576, 16384, 20480, Sb, sp + 4096, 4096, vsl, lane);
  }
}

struct GdnFrag { bf16x8 w[8], q[8], a[8], m[8], sb0, sb1; BF8 u0, u1, b0, b1; };

DEVFN void gdn_load(GdnFrag& f, const Params& p, int ci, int vsl, int lane) {
  const int kq = lane >> 4, l15 = lane & 15;
  const u16* cb = p.chunk() + (size_t)ci * 24576;
  const u16* sp = p.Sbuf() + ((size_t)ci * 4 + vsl) * 1024 + lane * 8;
  f.sb0 = *(const bf16x8*)sp; f.sb1 = *(const bf16x8*)(sp + 512);
  f.u0.q = *(const uint4*)(cb + 12288 + (vsl * 64 + lane) * 16);
  f.u1.q = *(const uint4*)(cb + 12288 + (vsl * 64 + lane) * 16 + 8);
#pragma unroll
  for (int mt = 0; mt < 4; ++mt) {
    const u16* r_ = cb + (mt * 16 + l15) * 64 + kq * 8;
    f.w[mt * 2] = *(const bf16x8*)r_; f.w[mt * 2 + 1] = *(const bf16x8*)(r_ + 32);
    f.q[mt * 2] = *(const bf16x8*)(r_ + 4096); f.q[mt * 2 + 1] = *(const bf16x8*)(r_ + 4096 + 32);
    f.a[mt * 2] = *(const bf16x8*)(r_ + 8192); f.a[mt * 2 + 1] = *(const bf16x8*)(r_ + 8192 + 32);
  }
}

DEVFN void gdn_mfma(const GdnFrag& f, f32x4 (&O)[4]) {
  f32x4 vn[4];
#pragma unroll
  for (int mt = 0; mt < 4; ++mt) {
    f32x4 c = f32x4{0.f, 0.f, 0.f, 0.f};
    c = MFMA16(f.w[mt * 2], f.sb0, c);
    c = MFMA16(f.w[mt * 2 + 1], f.sb1, c);
    const BF8& uu = (mt >> 1) ? f.u1 : f.u0;
    const unsigned u0 = uu.u[(mt & 1) * 2], u1 = uu.u[(mt & 1) * 2 + 1];
    vn[mt][0] = __uint_as_float(u0 << 16) - c[0];
    vn[mt][1] = __uint_as_float(u0 & 0xffff0000u) - c[1];
    vn[mt][2] = __uint_as_float(u1 << 16) - c[2];
    vn[mt][3] = __uint_as_float(u1 & 0xffff0000u) - c[3];
  }
  const bf16x8 Vb0 = pack8(vn[0], vn[1]), Vb1 = pack8(vn[2], vn[3]);
#pragma unroll
  for (int mt = 0; mt < 4; ++mt) {
    f32x4 c = f32x4{0.f, 0.f, 0.f, 0.f};
    c = MFMA16(f.q[mt * 2], f.sb0, c);
    c = MFMA16(f.q[mt * 2 + 1], f.sb1, c);
    c = MFMA16(f.a[mt * 2], Vb0, c);
    c = MFMA16(f.a[mt * 2 + 1], Vb1, c);
    O[mt] = c;
  }
}

DEVFN void gdn_epi(const Params& p, int ci, const f32x4 (&O)[4], float* red, int vsl, int lane) {
  const int kq = lane >> 4, l15 = lane & 15;
  const int n = ci & 127, bh = ci >> 7, h = bh & 7, b = bh >> 3;
  const int row0 = b * 8192 + n * 64;
  const int v = vsl * 16 + l15;
  u16* zbase = (u16*)p.out + 16777216 + (size_t)(row0 + kq * 4) * 1024 + 512 + h * 64 + v;
  u16 zv[16];
#pragma unroll
  for (int mt = 0; mt < 4; ++mt)
#pragma unroll
    for (int r = 0; r < 4; ++r) {
      zv[mt * 4 + r] = zbase[(size_t)(mt * 16 + r) * 1024];
      float ss = O[mt][r] * O[mt][r];
      ss = row16_sum(ss);
      if (l15 == 0) red[vsl * 64 + mt * 16 + kq * 4 + r] = ss;
    }
  __syncthreads();
  const float gw = p.gdn_norm_w[v];
#pragma unroll
  for (int mt = 0; mt < 4; ++mt)
#pragma unroll
    for (int r = 0; r < 4; ++r) {
      const int c = mt * 16 + kq * 4 + r;
      const float tot = red[c] + red[64 + c] + red[128 + c] + red[192 + c];
      const float rstd = rsqrtf(tot * (1.f / 64.f) + EPS);
      zbase[(size_t)(mt * 16 + r) * 1024] = f2bf(O[mt][r] * rstd * gw * bf2f(zv[mt * 4 + r]));
    }
  __syncthreads();
}


DEVFN void gdn_load_mb(GdnFrag& f, const Params& p, int ci, int vsl, int lane) {
  const int kq = lane >> 4, l15 = lane & 15;
  const u16* cb = p.chunk() + (size_t)ci * 24576;
  f.u0.q = *(const uint4*)(cb + 12288 + (vsl * 64 + lane) * 16);
  f.u1.q = *(const uint4*)(cb + 12288 + (vsl * 64 + lane) * 16 + 8);
  f.b0.q = *(const uint4*)(cb + 20480 + (vsl * 64 + lane) * 16);
  f.b1.q = *(const uint4*)(cb + 20480 + (vsl * 64 + lane) * 16 + 8);
#pragma unroll
  for (int mt = 0; mt < 4; ++mt) {
    const u16* r_ = cb + (mt * 16 + l15) * 64 + kq * 8;
    f.w[mt * 2] = *(const bf16x8*)r_; f.w[mt * 2 + 1] = *(const bf16x8*)(r_ + 32);
    f.q[mt * 2] = *(const bf16x8*)(r_ + 4096); f.q[mt * 2 + 1] = *(const bf16x8*)(r_ + 4096 + 32);
    f.a[mt * 2] = *(const bf16x8*)(r_ + 8192); f.a[mt * 2 + 1] = *(const bf16x8*)(r_ + 8192 + 32);
    f.m[mt * 2] = *(const bf16x8*)(r_ + 16384); f.m[mt * 2 + 1] = *(const bf16x8*)(r_ + 16384 + 32);
  }
}
DEVFN void gdn_advance(const GdnFrag& f, bf16x8& s0, bf16x8& s1) {
  f32x4 acc[4];
#pragma unroll
  for (int mt = 0; mt < 4; ++mt) {
    const BF8& bb = (mt >> 1) ? f.b1 : f.b0;
    const unsigned u0 = bb.u[(mt & 1) * 2], u1 = bb.u[(mt & 1) * 2 + 1];
    f32x4 c;
    c[0] = __uint_as_float(u0 << 16); c[1] = __uint_as_float(u0 & 0xffff0000u);
    c[2] = __uint_as_float(u1 << 16); c[3] = __uint_as_float(u1 & 0xffff0000u);
    c = MFMA16(f.m[mt * 2], s0, c);
    c = MFMA16(f.m[mt * 2 + 1], s1, c);
    acc[mt] = c;
  }
  s0 = pack8(acc[0], acc[1]);
  s1 = pack8(acc[2], acc[3]);
}

DEVFN void phase_gdn_out(const Params& p, char* smem) {
  const int tid = get_tid(), lane = tid & 63, wave = tid >> 6;
  float* red = (float*)smem;
  const int vsl = wave;
  if (gridDim.x == 512) {
    const int kq = lane >> 4, l15 = lane & 15;
    const int task = blockIdx.x >> 1, hs = blockIdx.x & 1;
    const int cg = (task >> 4) * 128 + (task & 15) * 8;
    const int c0 = cg + 4 * hs;
    u16* lds0 = (u16*)smem;
    float* red2 = (float*)(smem + 65536);
    const int row_w = tid >> 3, ch_w = tid & 7;
    const int woff = row_w * 64 + ((ch_w ^ ((row_w >> 1) & 7)) << 3);
    const int fsw = (l15 >> 1) & 7;
    u32x4s rg[2][8];
    BF8 ru[2][2], rq[2][2];
#define GO_LOAD(slot, ci_)                                                                    \
    {                                                                                          \
      const u16* cb_ = p.chunk() + (size_t)(ci_) * 24576;                                      \
      rg[slot][0] = *(const u32x4s*)(cb_ + tid * 8);                                           \
      rg[slot][1] = *(const u32x4s*)(cb_ + (tid + 256) * 8);                                   \
      rg[slot][2] = *(const u32x4s*)(cb_ + 4096 + tid * 8);                                    \
      rg[slot][3] = *(const u32x4s*)(cb_ + 4096 + (tid + 256) * 8);                            \
      rg[slot][4] = *(const u32x4s*)(cb_ + 8192 + tid * 8);                                    \
      rg[slot][5] = *(const u32x4s*)(cb_ + 8192 + (tid + 256) * 8);                            \
      rg[slot][6] = *(const u32x4s*)(cb_ + 16384 + tid * 8);                                   \
      rg[slot][7] = *(const u32x4s*)(cb_ + 16384 + (tid + 256) * 8);                           \
      ru[slot][0].q = *(const uint4*)(cb_ + 12288 + (vsl * 64 + lane) * 16);                   \
      ru[slot][1].q = *(const uint4*)(cb_ + 12288 + (vsl * 64 + lane) * 16 + 8);               \
      rq[slot][0].q = *(const uint4*)(cb_ + 20480 + (vsl * 64 + lane) * 16);                   \
      rq[slot][1].q = *(const uint4*)(cb_ + 20480 + (vsl * 64 + lane) * 16 + 8);               \
    }
#define GO_FRAG(lb_, k_, mt_, ks_) (*(const bf16x8*)((lb_) + (k_) * 4096 + ((mt_) * 16 + l15) * 64 + ((((ks_) * 4 + kq) ^ fsw) << 3)))
    GO_LOAD(0, c0)
    GO_LOAD(1, c0 + 1)
    const u16* sp = p.Sbuf() + ((size_t)cg * 4 + vsl) * 1024 + lane * 8;
    bf16x8 Sb[2];
    Sb[0] = *(const bf16x8*)sp;
    Sb[1] = *(const bf16x8*)(sp + 512);
    if (hs) scan_steps<1, false>((const u16*)(p.ws + GHALF_OFF) + (size_t)task * 8192, 0, 0, 4096, Sb, nullptr, 0, vsl, lane);
#pragma unroll
    for (int it = 0; it < 4; ++it) {
      const int sl = it & 1;
      const int ci = c0 + it;
      u16* lb = lds0 + sl * 16384;
#pragma unroll
      for (int k = 0; k < 4; ++k) {
        *(u32x4s*)(lb + k * 4096 + woff) = rg[sl][2 * k];
        *(u32x4s*)(lb + k * 4096 + woff + 32 * 64) = rg[sl][2 * k + 1];
      }
      const BF8 u0 = ru[sl][0], u1 = ru[sl][1], q0 = rq[sl][0], q1 = rq[sl][1];
      __syncthreads();
      if (it + 2 < 4) GO_LOAD(sl, ci + 2)
      f32x4 vn[4];
#pragma unroll
      for (int mt = 0; mt < 4; ++mt) {
        f32x4 c = f32x4{0.f, 0.f, 0.f, 0.f};
        c = MFMA16(GO_FRAG(lb, 0, mt, 0), Sb[0], c);
        c = MFMA16(GO_FRAG(lb, 0, mt, 1), Sb[1], c);
        const BF8& uu = (mt >> 1) ? u1 : u0;
        const unsigned a0 = uu.u[(mt & 1) * 2], a1 = uu.u[(mt & 1) * 2 + 1];
        vn[mt][0] = __uint_as_float(a0 << 16) - c[0];
        vn[mt][1] = __uint_as_float(a0 & 0xffff0000u) - c[1];
        vn[mt][2] = __uint_as_float(a1 << 16) - c[2];
        vn[mt][3] = __uint_as_float(a1 & 0xffff0000u) - c[3];
      }
      const bf16x8 Vb0 = pack8(vn[0], vn[1]), Vb1 = pack8(vn[2], vn[3]);
      f32x4 O[4];
#pragma unroll
      for (int mt = 0; mt < 4; ++mt) {
        f32x4 c = f32x4{0.f, 0.f, 0.f, 0.f};
        c = MFMA16(GO_FRAG(lb, 1, mt, 0), Sb[0], c);
        c = MFMA16(GO_FRAG(lb, 1, mt, 1), Sb[1], c);
        c = MFMA16(GO_FRAG(lb, 2, mt, 0), Vb0, c);
        c = MFMA16(GO_FRAG(lb, 2, mt, 1), Vb1, c);
        O[mt] = c;
      }
      if (it < 3) {
        f32x4 acc[4];
#pragma unroll
        for (int mt = 0; mt < 4; ++mt) {
          const BF8& bb = (mt >> 1) ? q1 : q0;
          const unsigned a0 = bb.u[(mt & 1) * 2], a1 = bb.u[(mt & 1) * 2 + 1];
          f32x4 c;
          c[0] = __uint_as_float(a0 << 16); c[1] = __uint_as_float(a0 & 0xffff0000u);
          c[2] = __uint_as_float(a1 << 16); c[3] = __uint_as_float(a1 & 0xffff0000u);
          c = MFMA16(GO_FRAG(lb, 3, mt, 0), Sb[0], c);
          c = MFMA16(GO_FRAG(lb, 3, mt, 1), Sb[1], c);
          acc[mt] = c;
        }
        Sb[0] = pack8(acc[0], acc[1]);
        Sb[1] = pack8(acc[2], acc[3]);
      }
      gdn_epi(p, ci, O, red2, vsl, lane);
    }
#undef GO_LOAD
#undef GO_FRAG
  } else {
    for (int ci = blockIdx.x; ci < 2048; ci += gridDim.x) {
      GdnFrag f;
      gdn_load(f, p, ci, vsl, lane);
      f32x4 O[4];
      gdn_mfma(f, O);
      gdn_epi(p, ci, O, red, vsl, lane);
    }
  }
}

DEVFN void phase3a(const Params& p, char* smem) {
  u16* out16 = (u16*)p.out;
  u16* T = (u16*)smem;
  for (int t = blockIdx.x; t < 512; t += gridDim.x) {
    int mt_ = t & 63, nt_ = t >> 6;
    if (gridDim.x == 512) {
      const int xcd = blockIdx.x & 7, j = blockIdx.x >> 3;
      mt_ = xcd * 8 + (j & 7);
      nt_ = j >> 3;
    }
    const int row0 = mt_ * 256, n0 = nt_ * 128;
#pragma unroll 1
    for (int half = 0; half < 2; ++half) {
      const int tid = get_tid(), lane = tid & 63, wave = tid >> 6, wr = wave >> 1, wc = wave & 1;
      const int kq = lane >> 4, l15 = lane & 15;
      f32x4 acc[8][4];
      zero_acc(acc);
      gemm_core(out16 + 16777216 + (size_t)row0 * 1024 + half * 512, 1024,
                (half ? p.WtUpB() : p.WtUpA()) + (size_t)n0 * 512, 512, 512, (u16*)smem, acc);
      u16* ytmp = half ? p.Pg() : p.merged();
#pragma unroll
      for (int mt = 0; mt < 8; ++mt)
#pragma unroll
        for (int r = 0; r < 4; ++r) {
          const int lrow = wr * 128 + mt * 16 + kq * 4 + r;
          stage4(T + lrow * 136 + wc * 64 + l15, acc[mt][0][r], acc[mt][1][r], acc[mt][2][r], acc[mt][3][r]);
        }
      __syncthreads();
#pragma unroll
      for (int i = 0; i < 16; ++i) {
        const int id = tid + 256 * i, lrow = id >> 4, pc = id & 15;
        *(uint4*)(ytmp + (size_t)(row0 + lrow) * 1024 + n0 + pc * 8) = *(const uint4*)(T + lrow * 136 + pc * 8);
      }
      __syncthreads();
      zero_acc(acc);
      gemm_core(out16 + (size_t)row0 * 1024, 1024, p.WtIn() + (size_t)(7168 + half * 1024 + n0) * 1024, 1024, 1024, (u16*)smem, acc);
#pragma unroll
      for (int mt = 0; mt < 8; ++mt)
#pragma unroll
        for (int r = 0; r < 4; ++r) {
          const int lrow = wr * 128 + mt * 16 + kq * 4 + r;
          stage4(T + lrow * 136 + wc * 64 + l15, sigm(acc[mt][0][r]), sigm(acc[mt][1][r]), sigm(acc[mt][2][r]), sigm(acc[mt][3][r]));
        }
      __syncthreads();
#pragma unroll 4
      for (int i = 0; i < 16; ++i) {
        const int id = tid + 256 * i, lrow = id >> 4, pc = id & 15;
        BF8 gt, y, m;
        gt.q = *(const uint4*)(T + lrow * 136 + pc * 8);
        y.q = *(const uint4*)(ytmp + (size_t)(row0 + lrow) * 1024 + n0 + pc * 8);
        u16* dst = p.merged() + (size_t)(row0 + lrow) * 1024 + n0 + pc * 8;
        if (half) m.q = *(const uint4*)dst; else m.q = make_uint4(0, 0, 0, 0);
#pragma unroll
        for (int e = 0; e < 4; ++e) {
          const float a0 = __uint_as_float(gt.u[e] << 16) * __uint_as_float(y.u[e] << 16) + __uint_as_float(m.u[e] << 16);
          const float a1 = __uint_as_float(gt.u[e] & 0xffff0000u) * __uint_as_float(y.u[e] & 0xffff0000u) + __uint_as_float(m.u[e] & 0xffff0000u);
          m.u[e] = pack2(a0, a1);
        }
        *(uint4*)dst = m.q;
      }
      __syncthreads();
    }
  }
}

DEVFN void phase3b(const Params& p, char* smem) {
  u16* T = (u16*)smem;
  u16* dl = p.Pg();
  for (int t = blockIdx.x; t < 512; t += gridDim.x) {
    int mt_ = t & 63, nt_ = t >> 6;
    if (gridDim.x == 512) {
      const int xcd = blockIdx.x & 7, j = blockIdx.x >> 3;
      mt_ = xcd * 8 + (j & 7);
      nt_ = j >> 3;
    }
    const int row0 = mt_ * 256, n0 = nt_ * 128;
    f32x4 acc[8][4];
    zero_acc(acc);
    gemm_core(p.merged() + (size_t)row0 * 1024, 1024, p.WtOut() + (size_t)n0 * 1024, 1024, 1024, (u16*)smem, acc);
    const int tid = get_tid(), lane = tid & 63, wave = tid >> 6, wr = wave >> 1, wc = wave & 1;
    const int kq = lane >> 4, l15 = lane & 15;
#pragma unroll
    for (int mt = 0; mt < 8; ++mt)
#pragma unroll
      for (int r = 0; r < 4; ++r) {
        const int lrow = wr * 128 + mt * 16 + kq * 4 + r;
        stage4(T + lrow * 136 + wc * 64 + l15, acc[mt][0][r], acc[mt][1][r], acc[mt][2][r], acc[mt][3][r]);
      }
    __syncthreads();
#pragma unroll
    for (int i = 0; i < 16; ++i) {
      const int id = tid + 256 * i, lrow = id >> 4, pc = id & 15;
      *(uint4*)(dl + (size_t)(row0 + lrow) * 1024 + n0 + pc * 8) = *(const uint4*)(T + lrow * 136 + pc * 8);
    }
    __syncthreads();
  }
}

DEVFN void phase4(const Params& p) {
  const int tid = get_tid(), lane = tid & 63, wave = tid >> 6;
  float4 fw[4];
#pragma unroll
  for (int i4 = 0; i4 < 4; ++i4) fw[i4] = ((const float4*)p.final_norm_w)[lane + 64 * i4];
  const u16* dl = p.Pg();
  for (int row = blockIdx.x * 4 + wave; row < 16384; row += gridDim.x * 4) {
    const float4* xr = (const float4*)(p.x + (size_t)row * 1024);
    const uint2* dr = (const uint2*)(dl + (size_t)row * 1024);
    float4 v[4];
    float ss = 0.f;
#pragma unroll
    for (int i4 = 0; i4 < 4; ++i4) {
      const float4 xv = xr[lane + 64 * i4];
      const uint2 d = dr[lane + 64 * i4];
      float4 t;
      t.x = xv.x + __uint_as_float(d.x << 16); t.y = xv.y + __uint_as_float(d.x & 0xffff0000u);
      t.z = xv.z + __uint_as_float(d.y << 16); t.w = xv.w + __uint_as_float(d.y & 0xffff0000u);
      v[i4] = t;
      ss += t.x * t.x + t.y * t.y + t.z * t.z + t.w * t.w;
    }
#pragma unroll
    for (int o = 32; o >= 1; o >>= 1) ss += __shfl_xor(ss, o);
    const float rs = __builtin_amdgcn_rsqf(ss * (1.f / 1024.f) + EPS);
    float4* o = (float4*)(p.out + (size_t)row * 1024);
#pragma unroll
    for (int i4 = 0; i4 < 4; ++i4) {
      float4 t = v[i4];
      t.x *= rs * fw[i4].x; t.y *= rs * fw[i4].y; t.z *= rs * fw[i4].z; t.w *= rs * fw[i4].w;
      o[lane + 64 * i4] = t;
    }
  }
}

#ifndef NO_MEGA
__global__ void __launch_bounds__(256, 2) fwd_megakernel(Params p) {
  __shared__ __attribute__((aligned(16))) char smem[SMEM_BYTES];
  __shared__ uint4 xb_words;
  cg::grid_group grid = cg::this_grid();
  if (threadIdx.x == 0) xb_words = make_uint4(0u, 0u, 0u, 0u);
  __syncthreads();
  if (p.ws == nullptr) grid.sync();
  XcdBarrier xb = xcd_barrier_post((unsigned*)(p.ws + 245956608ull), (volatile LAS unsigned*)&xb_words);
  phase0(p, smem);
  xcd_barrier(xb);
  phase1(p, smem);
  xcd_barrier(xb);
  phase_attn(p, smem);
  xcd_barrier(xb);
  phase_chunk(p, smem);
  xcd_barrier(xb);
  phase_scan_x1(p, smem);
  xcd_barrier(xb);
  phase_scan_merge(p, smem);
  xcd_barrier(xb);
  if (gridDim.x != 512) {
    phase_scan_x3(p);
    xcd_barrier(xb);
  }
  phase_gdn_out(p, smem);
  xcd_barrier(xb);
  phase3a(p, smem);
  xcd_barrier(xb);
  phase3b(p, smem);
  xcd_barrier(xb);
  phase4(p);
}

extern "C" void kernel_launch(void* const* d_in, const int* in_sizes, int n_in, void* d_out, int out_size,
                              void* d_ws, size_t ws_size, hipStream_t stream) {
  static int grid_blocks = 0;
  if (!grid_blocks) {
    int dev = 0, cus = 0, per_cu = 0;
    (void)hipGetDevice(&dev);
    (void)hipDeviceGetAttribute(&cus, hipDeviceAttributeMultiprocessorCount, dev);
    (void)hipOccupancyMaxActiveBlocksPerMultiprocessor(&per_cu, fwd_megakernel, NT, 0);
    if (per_cu > 2) per_cu = 2;
    if (per_cu < 1) per_cu = 1;
    grid_blocks = cus * per_cu;
  }
  Params p{};
  p.x = (const float*)d_in[0]; p.norm_w = (const float*)d_in[1]; p.w_in = (const float*)d_in[2];
  p.conv_w = (const float*)d_in[3]; p.a_log = (const float*)d_in[4]; p.dt_bias = (const float*)d_in[5];
  p.gdn_norm_w = (const float*)d_in[6]; p.w_up_a = (const float*)d_in[7]; p.w_up_b = (const float*)d_in[8];
  p.w_out = (const float*)d_in[9]; p.final_norm_w = (const float*)d_in[10];
  p.out = (float*)d_out;
  p.ws = (char*)d_ws;
  (void)hipMemsetAsync((char*)d_ws + 245956608ull, 0, XCD_BAR_WORDS * sizeof(unsigned), stream);
  void* args[] = {&p};
  hipError_t e = hipLaunchCooperativeKernel((void*)fwd_megakernel, dim3(grid_blocks), dim3(NT), args, 0, stream);
  if (e != hipSuccess) fprintf(stderr, "cooperative launch failed: %s (grid %d)\n", hipGetErrorString(e), grid_blocks);
}
#endif
```

```cpp
#include <hip/hip_runtime.h>
#include <hip/hip_cooperative_groups.h>
#include <stdint.h>
#include <stdio.h>
namespace cg = cooperative_groups;

typedef __attribute__((ext_vector_type(8))) short bf16x8;
typedef __attribute__((ext_vector_type(4))) float f32x4;
typedef unsigned short u16;

#define DEVFN __device__ __forceinline__

constexpr int SEQ = 8192, NWIN = 9232;
constexpr float EPS = 1e-6f;
constexpr int NT = 256;
constexpr int SMEM_BYTES = 73728;

#define DEVFN_ __device__ __forceinline__
struct Params {
  const float *x, *norm_w, *w_in, *conv_w, *a_log, *dt_bias, *gdn_norm_w, *w_up_a, *w_up_b, *w_out, *final_norm_w;
  float* out;
  char* ws;
  DEVFN_ u16* Qp() const { return (u16*)(ws); }
  DEVFN_ u16* Kp() const { return (u16*)(ws + 50331648ull); }
  DEVFN_ u16* Vt() const { return (u16*)(ws + 100663296ull); }
  DEVFN_ u16* Pg() const { return (u16*)(ws + 150994944ull); }
  DEVFN_ u16* WtIn() const { return (u16*)(ws + 201326592ull); }
  DEVFN_ u16* WtUpA() const { return (u16*)(ws + 220200960ull); }
  DEVFN_ u16* WtUpB() const { return (u16*)(ws + 221249536ull); }
  DEVFN_ u16* WtOut() const { return (u16*)(ws + 222298112ull); }
  DEVFN_ float* ropeC() const { return (float*)(ws + 224395264ull); }
  DEVFN_ float* ropeS() const { return (float*)(ws + 225443840ull); }
  DEVFN_ float* bg() const { return (float*)(ws + 226492416ull); }
  DEVFN_ float* lse() const { return (float*)(ws + 227540992ull); }
  DEVFN_ float* rowss() const { return (float*)(ws + 229113856ull); }
  DEVFN_ u16* Sbuf() const { return (u16*)(ws + 229179392ull); }
  DEVFN_ u16* chunk() const { return Kp(); }
  DEVFN_ u16* merged() const { return Qp(); }
};

DEVFN int get_tid() { int t = threadIdx.x; asm volatile("" : "+v"(t)); return t; }
typedef __attribute__((ext_vector_type(2))) __bf16 bf16x2_t;
typedef __attribute__((ext_vector_type(2))) float f32x2_t;
DEVFN unsigned pack2(float a, float b) {
  f32x2_t v = {a, b};
  bf16x2_t r = __builtin_convertvector(v, bf16x2_t);
  return __builtin_bit_cast(unsigned, r);
}
DEVFN u16 f2bf(float f) { return (u16)(pack2(f, 0.f) & 0xffffu); }
DEVFN float bf2f(u16 h) { return __uint_as_float(((unsigned)h) << 16); }
DEVFN float sigm(float x) { return __builtin_amdgcn_rcpf(1.f + __expf(-x)); }
DEVFN float silu(float x) { return x * __builtin_amdgcn_rcpf(1.f + __expf(-x)); }
DEVFN void stage4(u16* trow, float v0, float v1, float v2, float v3) {
  const unsigned p01 = pack2(v0, v1), p23 = pack2(v2, v3);
  trow[0] = (u16)(p01 & 0xffffu); trow[16] = (u16)(p01 >> 16);
  trow[32] = (u16)(p23 & 0xffffu); trow[48] = (u16)(p23 >> 16);
}

DEVFN float row16_sum(float x) {
  x += __builtin_bit_cast(float, __builtin_amdgcn_update_dpp(0, __builtin_bit_cast(int, x), 0x128, 0xF, 0xF, false));
  x += __builtin_bit_cast(float, __builtin_amdgcn_update_dpp(0, __builtin_bit_cast(int, x), 0x124, 0xF, 0xF, false));
  x += __builtin_bit_cast(float, __builtin_amdgcn_update_dpp(0, __builtin_bit_cast(int, x), 0x122, 0xF, 0xF, false));
  x += __builtin_bit_cast(float, __builtin_amdgcn_update_dpp(0, __builtin_bit_cast(int, x), 0x121, 0xF, 0xF, false));
  return x;
}

DEVFN int permk(int j) { return (j & 32) | ((j & 12) << 1) | ((j & 16) >> 2) | (j & 3); }

union BF8 { bf16x8 v; unsigned u[4]; uint4 q; };

DEVFN bf16x8 pack8(const f32x4& a, const f32x4& b) {
  BF8 r;
  r.u[0] = pack2(a[0], a[1]); r.u[1] = pack2(a[2], a[3]);
  r.u[2] = pack2(b[0], b[1]); r.u[3] = pack2(b[2], b[3]);
  return r.v;
}

#define MFMA16(a, b, c) __builtin_amdgcn_mfma_f32_16x16x32_bf16((a), (b), (c), 0, 0, 0)
#define MFMAF32(a, b, c) __builtin_amdgcn_mfma_f32_16x16x4f32((a), (b), (c), 0, 0, 0)

#define XB_TMO      128
#define XB_XCNT(j)  (256  + 64 * (j))
#define XB_XSUB(j)  (1280 + 64 * (j))
#define XB_XGEN(j)  (2304 + 64 * (j))
#define XB_TOP      3328
#define XB_TOPGEN   3392
#define XCD_BAR_WORDS 3456
#define XB_SPIN_CAP (1u << 18)
#define LAS __attribute__((address_space(3)))

__device__ __forceinline__ unsigned xb_ld(unsigned* p)              { return __hip_atomic_load(p, __ATOMIC_RELAXED, __HIP_MEMORY_SCOPE_AGENT); }
__device__ __forceinline__ unsigned xb_add(unsigned* p, unsigned v) { return __hip_atomic_fetch_add(p, v, __ATOMIC_RELAXED, __HIP_MEMORY_SCOPE_AGENT); }
__device__ __forceinline__ unsigned xb_xcc_id() { return (unsigned)__builtin_amdgcn_s_getreg((3 << 11) | 20) & 0xFu; }
#define XB_SPIN(cond, bar) do { unsigned _sp = 0; while (cond) { __builtin_amdgcn_s_sleep(1); \
    if ((++_sp & 255u) == 0u) { if (xb_ld(&(bar)[XB_TMO])) break; if (_sp > XB_SPIN_CAP) { atomicAdd(&(bar)[XB_TMO], 1u); break; } } } } while (0)

struct XcdBarrier {
    unsigned* bar; unsigned x;
    volatile LAS unsigned* st;
};

__device__ __forceinline__ XcdBarrier xcd_barrier_post(unsigned* bar, volatile LAS unsigned* st) {
    XcdBarrier b; b.bar = bar; b.x = xb_xcc_id(); b.st = st;
    if (threadIdx.x == 0) (void)xb_add(&bar[XB_XCNT(b.x)], 1u);
    return b;
}
__device__ __forceinline__ void xcd_barrier_complete(unsigned* bar, unsigned x, unsigned& nloc, unsigned& nx) {
    const unsigned G = gridDim.x * gridDim.y * gridDim.z;
    unsigned sum, cnt, mine, sp = 0u;
    for (;;) {
        sum = 0u; cnt = 0u; mine = 0u;
#pragma unroll
        for (unsigned j = 0; j < 16; ++j) { const unsigned c = xb_ld(&bar[XB_XCNT(j)]); sum += c; cnt += (c > 0u) ? 1u : 0u; mine = (j == x) ? c : mine; }
        if (sum == G) break;
        __builtin_amdgcn_s_sleep(1);
        if ((++sp & 255u) == 0u) { if (xb_ld(&bar[XB_TMO])) break; if (sp > XB_SPIN_CAP) { atomicAdd(&bar[XB_TMO], 1u); break; } }
    }
    nloc = mine > 0u ? mine : 1u; nx = cnt > 0u ? cnt : 1u;
}

__device__ __forceinline__ void xcd_barrier(const XcdBarrier& b) {
    asm volatile("s_waitcnt vmcnt(0)" ::: "memory");
    __syncthreads();
    if (threadIdx.x == 0) {
        unsigned* bar = b.bar;
        __builtin_amdgcn_s_waitcnt(0);
        unsigned nloc = b.st[0], nx = b.st[1];
        if (nloc == 0u) { xcd_barrier_complete(bar, b.x, nloc, nx); b.st[0] = nloc; b.st[1] = nx; }
        const unsigned old = xb_add(&bar[XB_XSUB(b.x)], 1u);
        const unsigned gen = old / nloc;
        if (old + 1u == (gen + 1u) * nloc) {
            __builtin_amdgcn_fence(__ATOMIC_RELEASE, "agent");
            asm volatile("s_waitcnt vmcnt(0)" ::: "memory");
            const unsigned og = xb_add(&bar[XB_TOP], 1u);
            const unsigned tg = og / nx;
            if (og + 1u == (tg + 1u) * nx) xb_add(&bar[XB_TOPGEN], 1u);
            else XB_SPIN(xb_ld(&bar[XB_TOPGEN]) == tg, bar);
            __builtin_amdgcn_fence(__ATOMIC_ACQUIRE, "agent");
            xb_add(&bar[XB_XGEN(b.x)], 1u);
            asm volatile("s_waitcnt vmcnt(0)" ::: "memory");
        } else {
            XB_SPIN(xb_ld(&bar[XB_XGEN(b.x)]) == gen, bar);
            __builtin_amdgcn_fence(__ATOMIC_ACQUIRE, "agent");
            asm volatile("s_waitcnt vmcnt(0)" ::: "memory");
        }
    }
    __syncthreads();
}


DEVFN void gemm_core(const u16* __restrict__ A, int lda, const u16* __restrict__ B, int ldb, int K,
                     u16* sm, f32x4 (&acc)[8][4]) {
  const int tid = get_tid(), lane = tid & 63, wave = tid >> 6, wr = wave >> 1, wc = wave & 1;
  const int lrow = tid >> 2, lc = tid & 3;
  const int wofs = lrow * 32 + ((lc ^ ((4 - ((lrow >> 2) & 3)) & 3)) << 3);
  const int l15 = lane & 15, kq = lane >> 4;
  const int co = ((kq ^ ((4 - (l15 >> 2)) & 3)) << 3);
  uint4 ra0_0, ra0_1, ra0_2, ra0_3, rb0_0, rb0_1, ra1_0, ra1_1, ra1_2, ra1_3, rb1_0, rb1_1;
  const u16* Ap = A + (size_t)lrow * lda + lc * 8;
  const u16* Bp = B + (size_t)lrow * ldb + lc * 8;
#define G_LOADA(RA, k0, i) RA##_##i = *(const uint4*)(Ap + (size_t)(64 * i) * lda + (k0));
#define G_LOADB(RB, k0, i) RB##_##i = *(const uint4*)(Bp + (size_t)(64 * i) * ldb + (k0));
#define G_LOAD(RA, RB, k0) G_LOADA(RA, k0, 0) G_LOADA(RA, k0, 1) G_LOADA(RA, k0, 2) G_LOADA(RA, k0, 3) G_LOADB(RB, k0, 0) G_LOADB(RB, k0, 1)
#define G_STOREA(RA, buf, i) *(uint4*)(sm + (buf) * 12288 + 64 * i * 32 + wofs) = RA##_##i;
#define G_STOREB(RB, buf, i) *(uint4*)(sm + (buf) * 12288 + 8192 + 64 * i * 32 + wofs) = RB##_##i;
#define G_STORE(RA, RB, buf) G_STOREA(RA, buf, 0) G_STOREA(RA, buf, 1) G_STOREA(RA, buf, 2) G_STOREA(RA, buf, 3) G_STOREB(RB, buf, 0) G_STOREB(RB, buf, 1)
#define G_COMPUTE(buf)                                                                         \
  {                                                                                            \
    const u16* as = sm + (buf) * 12288 + (wr * 128 + l15) * 32 + co;                           \
    const u16* bs = sm + (buf) * 12288 + 8192 + (wc * 64 + l15) * 32 + co;                     \
    bf16x8 b[4];                                                                               \
    _Pragma("unroll") for (int nt = 0; nt < 4; ++nt) b[nt] = *(const bf16x8*)(bs + nt * 512); \
    bf16x8 a[8];                                                                               \
    _Pragma("unroll") for (int mt = 0; mt < 8; ++mt) a[mt] = *(const bf16x8*)(as + mt * 512);  \
    __builtin_amdgcn_s_setprio(1);                                                             \
    _Pragma("unroll") for (int mt = 0; mt < 8; ++mt) {                                         \
      _Pragma("unroll") for (int nt = 0; nt < 4; ++nt) acc[mt][nt] = MFMA16(a[mt], b[nt], acc[mt][nt]); \
    }                                                                                          \
    __builtin_amdgcn_s_setprio(0);                                                             \
  }
  const int nk = K >> 5;
  G_LOAD(ra0, rb0, 0)
  G_LOAD(ra1, rb1, 32)
  G_STORE(ra0, rb0, 0)
  __syncthreads();
#pragma unroll 1
  for (int kt = 0; kt < nk; kt += 2) {
    const int k2 = (kt + 2 < nk ? kt + 2 : nk - 1) * 32, k3 = (kt + 3 < nk ? kt + 3 : nk - 1) * 32;
    G_LOAD(ra0, rb0, k2)
    G_COMPUTE(0)
    G_STORE(ra1, rb1, 1)
    __syncthreads();
    G_LOAD(ra1, rb1, k3)
    G_COMPUTE(1)
    G_STORE(ra0, rb0, 0)
    __syncthreads();
  }
#undef G_LOAD
#undef G_STORE
#undef G_LOADA
#undef G_LOADB
#undef G_STOREA
#undef G_STOREB
#undef G_COMPUTE
}

DEVFN void zero_acc(f32x4 (&acc)[8][4]) {
#pragma unroll
  for (int i = 0; i < 8; ++i)
#pragma unroll
    for (int j = 0; j < 4; ++j) acc[i][j] = f32x4{0.f, 0.f, 0.f, 0.f};
}

DEVFN void transpose_tile(const float* __restrict__ src, int ld, int K, u16* __restrict__ dst, int k0, int n0, int nsrc, float* ts) {
  const int tid = get_tid();
#pragma unroll
  for (int i = 0; i < 4; ++i) {
    const int idx = tid + NT * i, kk = idx >> 4, n4 = (idx & 15) * 4;
    const float4 v = *(const float4*)(src + (size_t)(k0 + kk) * ld + nsrc + n4);
    ts[kk * 65 + n4 + 0] = v.x; ts[kk * 65 + n4 + 1] = v.y; ts[kk * 65 + n4 + 2] = v.z; ts[kk * 65 + n4 + 3] = v.w;
  }
  __syncthreads();
#pragma unroll
  for (int i = 0; i < 4; ++i) {
    const int idx = tid + NT * i, nn = idx >> 4, k4 = (idx & 15) * 4;
    uint2 pk;
    pk.x = pack2(ts[(k4 + 0) * 65 + nn], ts[(k4 + 1) * 65 + nn]);
    pk.y = pack2(ts[(k4 + 2) * 65 + nn], ts[(k4 + 3) * 65 + nn]);
    *(uint2*)(dst + (size_t)(n0 + nn) * K + k0 + k4) = pk;
  }
  __syncthreads();
}

DEVFN void phase0(const Params& p, char* smem) {
  const int tid = get_tid(), lane = tid & 63, wave = tid >> 6;
  const int bid = blockIdx.x, nb = gridDim.x;
  float* ts = (float*)smem;
  for (int t = bid; t < 1792; t += nb) {
    const int n0 = (t >> 4) * 64, k0 = (t & 15) * 64;
    transpose_tile(p.w_in, NWIN, 1024, p.WtIn(), k0, n0, n0, ts);
  }
  for (int idx = bid * NT + tid; idx < SEQ * 32; idx += nb * NT) {
    int pos = idx >> 5, i = idx & 31;
    float inv = powf(10000.f, -(float)i / 32.f);
    float ang = (float)pos * inv;
    double a = (double)ang;
    double n = rint(a * 0.15915494309189535);
    float r = (float)(a - n * 6.283185307179586);
    p.ropeC()[idx] = cosf(r);
    p.ropeS()[idx] = sinf(r);
    if (idx < 16384) p.rowss()[idx] = 0.f;
  }
  float* wt = (float*)smem;
  for (int idx = tid; idx < 4096; idx += NT) {
    const int k = idx & 1023, j4 = idx >> 10;
    const float4 w4 = *(const float4*)(p.w_in + (size_t)k * NWIN + 7168 + 4 * j4);
    wt[(4 * j4 + 0) * 1024 + k] = w4.x; wt[(4 * j4 + 1) * 1024 + k] = w4.y;
    wt[(4 * j4 + 2) * 1024 + k] = w4.z; wt[(4 * j4 + 3) * 1024 + k] = w4.w;
  }
  __syncthreads();
  float4 nw[4];
#pragma unroll
  for (int i4 = 0; i4 < 4; ++i4) nw[i4] = ((const float4*)p.norm_w)[lane + 64 * i4];
  u16* h16 = (u16*)p.out;
  for (int grp = bid * 4 + wave; grp < 4096; grp += nb * 4) {
    float4 hv[4][4];
#pragma unroll
    for (int r = 0; r < 4; ++r) {
      const int row = grp * 4 + r;
      const float4* xr = (const float4*)(p.x + (size_t)row * 1024);
      float ss = 0.f;
#pragma unroll
      for (int i4 = 0; i4 < 4; ++i4) {
        float4 v = xr[lane + 64 * i4];
        hv[r][i4] = v;
        ss += v.x * v.x + v.y * v.y + v.z * v.z + v.w * v.w;
      }
#pragma unroll
      for (int o = 32; o >= 16; o >>= 1) ss += __shfl_xor(ss, o);
    ss = row16_sum(ss);
      const float rs = rsqrtf(ss * (1.f / 1024.f) + EPS);
#pragma unroll
      for (int i4 = 0; i4 < 4; ++i4) {
        float4 v = hv[r][i4];
        v.x *= rs * nw[i4].x; v.y *= rs * nw[i4].y; v.z *= rs * nw[i4].z; v.w *= rs * nw[i4].w;
        hv[r][i4] = v;
        uint2 pk; pk.x = pack2(v.x, v.y); pk.y = pack2(v.z, v.w);
        *(uint2*)(h16 + (size_t)row * 1024 + 4 * (lane + 64 * i4)) = pk;
      }
    }
    float myval = 0.f;
    const bool up5 = (lane & 32) != 0, up4 = (lane & 16) != 0, up1 = (lane & 2) != 0, up0 = (lane & 1) != 0;
#pragma unroll 1
    for (int jj = 0; jj < 4; ++jj) {
      float a[4][4];
#pragma unroll
      for (int r = 0; r < 4; ++r)
#pragma unroll
        for (int q = 0; q < 4; ++q) a[r][q] = 0.f;
#pragma unroll
      for (int q = 0; q < 4; ++q)
#pragma unroll
        for (int i4 = 0; i4 < 4; ++i4) {
          const float4 w4 = ((const float4*)(wt + (4 * jj + q) * 1024))[lane + 64 * i4];
#pragma unroll
          for (int r = 0; r < 4; ++r)
            a[r][q] += hv[r][i4].x * w4.x + hv[r][i4].y * w4.y + hv[r][i4].z * w4.z + hv[r][i4].w * w4.w;
        }
      float b[2][4], c[4], d[2];
#pragma unroll
      for (int rr = 0; rr < 2; ++rr)
#pragma unroll
        for (int q = 0; q < 4; ++q) {
          const float send = up5 ? a[rr][q] : a[rr + 2][q], keep = up5 ? a[rr + 2][q] : a[rr][q];
          b[rr][q] = keep + __shfl_xor(send, 32);
        }
#pragma unroll
      for (int q = 0; q < 4; ++q) {
        const float send = up4 ? b[0][q] : b[1][q], keep = up4 ? b[1][q] : b[0][q];
        c[q] = keep + __shfl_xor(send, 16);
      }
#pragma unroll
      for (int qq = 0; qq < 2; ++qq) {
        const float send = up1 ? c[qq] : c[qq + 2], keep = up1 ? c[qq + 2] : c[qq];
        d[qq] = keep + __shfl_xor(send, 2);
      }
      float e;
      {
        const float send = up0 ? d[0] : d[1], keep = up0 ? d[1] : d[0];
        e = keep + __shfl_xor(send, 1);
      }
      e += __shfl_xor(e, 8);
      e += __shfl_xor(e, 4);
      if (((lane >> 2) & 3) == jj) myval = e;
    }
    {
      const int r = lane >> 4, j = lane & 15;
      const int row = grp * 4 + r;
      float val = myval, res;
      if (j < 8) res = sigm(val);
      else {
        const int hh = j - 8;
        const float z = val + p.dt_bias[hh];
        const float sp = fmaxf(z, 0.f) + log1pf(__expf(-fabsf(z)));
        res = -__expf(p.a_log[hh]) * sp;
      }
      p.bg()[(size_t)row * 16 + j] = res;
    }
  }
  __syncthreads();
}

DEVFN void phase1(const Params& p, char* smem) {
  u16* out16 = (u16*)p.out;
  u16* T = (u16*)smem;
  for (int t = blockIdx.x; t < 64 * 56; t += gridDim.x) {
    const int tid = get_tid(), lane = tid & 63, wave = tid >> 6, wr = wave >> 1, wc = wave & 1;
    const int kq = lane >> 4, l15 = lane & 15;
    int mt_ = t & 63, nt_ = t >> 6;
    if (gridDim.x == 512) {
      const int xcd = blockIdx.x & 7, j = blockIdx.x >> 3, i = t >> 9;
      mt_ = xcd * 8 + (j & 7);
      nt_ = i * 8 + (j >> 3);
    }
    const int row0 = mt_ * 256;
    f32x4 acc[8][4];
    zero_acc(acc);
    gemm_core(out16 + (size_t)row0 * 1024, 1024, p.WtIn() + (size_t)(nt_ * 128) * 1024, 1024, 1024, (u16*)smem, acc);
    const int bq = row0 >> 13;
    const int s0 = row0 & 8191;
    if (nt_ < 36) {
      const int g = nt_ / 12, tt = (nt_ % 12) >> 2;
      const int sh = 2 * g;
      if (tt < 2) {
        const float sc = (tt == 0) ? 0.18033688011112042f : 1.f;
#pragma unroll
        for (int mt = 0; mt < 8; ++mt)
#pragma unroll
          for (int r = 0; r < 4; ++r) {
            const int lrow = wr * 128 + mt * 16 + kq * 4 + r;
            const int s = s0 + lrow;
#pragma unroll
            for (int nt = 0; nt < 2; ++nt) {
              const int d = nt * 16 + l15;
              const float c = p.ropeC()[s * 32 + d], sn = p.ropeS()[s * 32 + d];
              const float lo = acc[mt][nt][r], hi = acc[mt][nt + 2][r];
              T[lrow * 136 + wc * 64 + d] = f2bf((lo * c - hi * sn) * sc);
              T[lrow * 136 + wc * 64 + d + 32] = f2bf((hi * c + lo * sn) * sc);
            }
          }
        __syncthreads();
        u16* dstb = (tt == 0 ? p.Qp() : p.Kp());
#pragma unroll
        for (int i = 0; i < 16; ++i) {
          const int id = tid + 256 * i, lrow = id >> 4, pc = id & 15;
          const uint4 v = *(const uint4*)(T + lrow * 136 + pc * 8);
          const int s = s0 + lrow;
          const int pos = ((s & ((1 << sh) - 1)) << (13 - sh)) + (s >> sh);
          const int head = ((nt_ & 3) << 1) + (pc >> 3);
          const size_t hb = (size_t)((bq * 3 + g) * 8 + head);
          *(uint4*)(dstb + (hb * 8192 + pos) * 64 + (pc & 7) * 8) = v;
        }
      } else {
#pragma unroll
        for (int mt = 0; mt < 8; ++mt)
#pragma unroll
          for (int r = 0; r < 4; ++r) {
            const int lrow = wr * 128 + mt * 16 + kq * 4 + r;
            const int rho = ((lrow & ((1 << sh) - 1)) << (8 - sh)) + (lrow >> sh);
#pragma unroll
            for (int nt = 0; nt < 4; ++nt) T[(wc * 64 + nt * 16 + l15) * 264 + rho] = f2bf(acc[mt][nt][r]);
          }
        __syncthreads();
#pragma unroll
        for (int i = 0; i < 16; ++i) {
          const int id = tid + 256 * i, col = id >> 5, q = id & 31;
          const uint4 v = *(const uint4*)(T + col * 264 + q * 8);
          const int rho0 = q * 8;
          const int r_ = rho0 >> (8 - sh), j0 = rho0 & ((256 >> sh) - 1);
          const int pos = (r_ << (13 - sh)) + (s0 >> sh) + j0;
          const int head = ((nt_ & 3) << 1) + (col >> 6), d = col & 63;
          const size_t hb = (size_t)((bq * 3 + g) * 8 + head);
          *(uint4*)(p.Vt() + (hb * 64 + d) * 8192 + pos) = v;
        }
      }
    } else {
      u16* dst; int ldd; bool act;
      if (nt_ < 40) { dst = out16 + 16777216 + (nt_ - 36) * 128; ldd = 1024; act = true; }
      else if (nt_ < 52) { dst = p.Pg() + (nt_ - 40) * 128; ldd = 1536; act = false; }
      else { dst = out16 + 16777216 + 512 + (nt_ - 52) * 128; ldd = 1024; act = true; }
#pragma unroll
      for (int mt = 0; mt < 8; ++mt)
#pragma unroll
        for (int r = 0; r < 4; ++r) {
          const int lrow = wr * 128 + mt * 16 + kq * 4 + r;
          float v4[4];
#pragma unroll
          for (int nt = 0; nt < 4; ++nt) { float v = acc[mt][nt][r]; if (act) v = silu(v); v4[nt] = v; }
          stage4(T + lrow * 136 + wc * 64 + l15, v4[0], v4[1], v4[2], v4[3]);
        }
      __syncthreads();
#pragma unroll
      for (int i = 0; i < 16; ++i) {
        const int id = tid + 256 * i, lrow = id >> 4, pc = id & 15;
        const uint4 v = *(const uint4*)(T + lrow * 136 + pc * 8);
        *(uint4*)(dst + (size_t)(row0 + lrow) * ldd + pc * 8) = v;
      }
    }
    __syncthreads();
  }
}

DEVFN void phase_attn(const Params& p, char* smem) {
  const int tid = get_tid(), lane = tid & 63, wave = tid >> 6;
  const int kq = lane >> 4, l15 = lane & 15;
  u16* Ks = (u16*)smem;
  u16* Vs = Ks + 256 * 72;
  uint4 kr_0, kr_1, kr_2, kr_3, kr_4, kr_5, kr_6, kr_7, vr_0, vr_1, vr_2, vr_3, vr_4, vr_5, vr_6, vr_7;
  bf16x8 qn_00, qn_01, qn_10, qn_11;
#define ATT_LDK(i) kr_##i = *(const uint4*)(kp_ + 32 * i * 64);
#define ATT_LDV(i) vr_##i = *(const uint4*)(vp_ + (long)(8 * i) * 8192);
#define ATT_LOADKQ(it)                                                                                 \
  {                                                                                                     \
    const int kb_ = (it) & 63, base_ = (it) >> 6, p0_ = kb_ * 128;                                      \
    const u16* kp_ = p.Kp() + (((long)base_ * 8192 + p0_ - 128) * 64 + (tid >> 3) * 64 + (tid & 7) * 8); \
    ATT_LDK(0) ATT_LDK(1) ATT_LDK(2) ATT_LDK(3) ATT_LDK(4) ATT_LDK(5) ATT_LDK(6) ATT_LDK(7)             \
    const u16* Qn_ = p.Qp() + ((size_t)base_ * 8192 + p0_ + 32 * wave) * 64 + l15 * 64 + kq * 8;        \
    qn_00 = *(const bf16x8*)(Qn_); qn_01 = *(const bf16x8*)(Qn_ + 32);                                  \
    qn_10 = *(const bf16x8*)(Qn_ + 1024); qn_11 = *(const bf16x8*)(Qn_ + 1024 + 32);                    \
  }
#define ATT_LOADV(it)                                                                                  \
  {                                                                                                     \
    const int kb_ = (it) & 63, base_ = (it) >> 6, p0_ = kb_ * 128;                                      \
    const u16* vp_ = p.Vt() + ((long)base_ * 64 * 8192 + p0_ - 128 + (long)(tid >> 5) * 8192 + (tid & 31) * 8); \
    ATT_LDV(0) ATT_LDV(1) ATT_LDV(2) ATT_LDV(3) ATT_LDV(4) ATT_LDV(5) ATT_LDV(6) ATT_LDV(7)             \
  }
#define ATT_STK(i) *(uint4*)(Ks + ((tid >> 3) + 32 * i) * 72 + (tid & 7) * 8) = kr_##i;
#define ATT_STV(i) *(uint4*)(Vs + ((tid >> 5) + 8 * i) * 264 + (tid & 31) * 8) = vr_##i;
  ATT_LOADKQ(blockIdx.x < 3072 ? (int)blockIdx.x : 0)
  for (int item = blockIdx.x; item < 3072; item += gridDim.x) {
    const int kb = item & 63, base = item >> 6;
    const int h = base & 7, bg_ = base >> 3, g = bg_ % 3, b = bg_ / 3;
    const int sh = 2 * g, sublen = 8192 >> sh;
    const int p0 = kb * 128;
    const bool first = ((p0 & (sublen - 1)) == 0);
    ATT_STK(0) ATT_STK(1) ATT_STK(2) ATT_STK(3) ATT_STK(4) ATT_STK(5) ATT_STK(6) ATT_STK(7)
    bf16x8 qf[2][2];
    qf[0][0] = qn_00; qf[0][1] = qn_01; qf[1][0] = qn_10; qf[1][1] = qn_11;
    __syncthreads();
    u16* Qg = p.Qp() + ((size_t)base * 8192 + p0 + 32 * wave) * 64;
    ATT_LOADV(item)
    {
      const int nxt = item + gridDim.x;
      const int itl = nxt < 3072 ? nxt : item;
      ATT_LOADKQ(itl)
    }
    __builtin_amdgcn_sched_barrier(0);
    f32x4 st[10][2];
#pragma unroll
    for (int mt = 0; mt < 10; ++mt) {
      const u16* kr = Ks + (32 * wave + mt * 16 + l15) * 72 + kq * 8;
      const bf16x8 k0 = *(const bf16x8*)kr, k1 = *(const bf16x8*)(kr + 32);
#pragma unroll
      for (int nt = 0; nt < 2; ++nt) {
        f32x4 c = f32x4{0.f, 0.f, 0.f, 0.f};
        if (mt - nt >= 0 && mt - nt <= 8) {
          c = MFMA16(k0, qf[nt][0], c);
          c = MFMA16(k1, qf[nt][1], c);
        }
        st[mt][nt] = c;
      }
    }
    float mx[2] = {-1e30f, -1e30f};
#pragma unroll
    for (int mt = 0; mt < 10; ++mt)
#pragma unroll
      for (int nt = 0; nt < 2; ++nt) {
        const int dd = mt - nt;
#pragma unroll
        for (int r = 0; r < 4; ++r) {
          float s = st[mt][nt][r];
          if (dd < 0 || dd > 8) s = -1e30f;
          else if (dd == 0) { if (kq * 4 + r - l15 < 0) s = -1e30f; }
          else if (dd == 8) { if (kq * 4 + r - l15 > 0) s = -1e30f; }
          st[mt][nt][r] = s;
        }
      }
    if (first) {
#pragma unroll
      for (int mt = 0; mt < 10; ++mt)
#pragma unroll
        for (int nt = 0; nt < 2; ++nt)
#pragma unroll
          for (int r = 0; r < 4; ++r)
            if (32 * wave + mt * 16 + kq * 4 + r < 128) st[mt][nt][r] = -1e30f;
    }
#pragma unroll
    for (int mt = 0; mt < 10; ++mt)
#pragma unroll
      for (int nt = 0; nt < 2; ++nt)
#pragma unroll
        for (int r = 0; r < 4; ++r) mx[nt] = fmaxf(mx[nt], st[mt][nt][r]);
    float sum[2] = {0.f, 0.f};
#pragma unroll
    for (int nt = 0; nt < 2; ++nt) {
      mx[nt] = fmaxf(mx[nt], __shfl_xor(mx[nt], 16));
      mx[nt] = fmaxf(mx[nt], __shfl_xor(mx[nt], 32));
    }
#pragma unroll
    for (int mt = 0; mt < 10; ++mt)
#pragma unroll
      for (int nt = 0; nt < 2; ++nt)
#pragma unroll
        for (int r = 0; r < 4; ++r) {
          const float e = __builtin_amdgcn_exp2f(st[mt][nt][r] - mx[nt]);
          st[mt][nt][r] = e;
          sum[nt] += e;
        }
#pragma unroll
    for (int nt = 0; nt < 2; ++nt) {
      sum[nt] += __shfl_xor(sum[nt], 16);
      sum[nt] += __shfl_xor(sum[nt], 32);
    }
    ATT_STV(0) ATT_STV(1) ATT_STV(2) ATT_STV(3) ATT_STV(4) ATT_STV(5) ATT_STV(6) ATT_STV(7)
    __syncthreads();
    f32x4 ot[4][2];
#pragma unroll
    for (int dt = 0; dt < 4; ++dt)
#pragma unroll
      for (int nt = 0; nt < 2; ++nt) ot[dt][nt] = f32x4{0.f, 0.f, 0.f, 0.f};
#pragma unroll
    for (int t = 0; t < 5; ++t) {
      bf16x8 pf[2];
#pragma unroll
      for (int nt = 0; nt < 2; ++nt) pf[nt] = pack8(st[2 * t][nt], st[2 * t + 1][nt]);
#pragma unroll
      for (int dt = 0; dt < 4; ++dt) {
        const u16* vr = Vs + (dt * 16 + l15) * 264 + 32 * wave + 32 * t + kq * 4;
        BF8 vf;
        const uint2 lo = *(const uint2*)vr, hi = *(const uint2*)(vr + 16);
        vf.u[0] = lo.x; vf.u[1] = lo.y; vf.u[2] = hi.x; vf.u[3] = hi.y;
#pragma unroll
        for (int nt = 0; nt < 2; ++nt) ot[dt][nt] = MFMA16(vf.v, pf[nt], ot[dt][nt]);
      }
    }
#pragma unroll
    for (int nt = 0; nt < 2; ++nt) {
      const float inv = 1.f / sum[nt];
#pragma unroll
      for (int dt = 0; dt < 4; ++dt) {
        uint2 pk;
        pk.x = pack2(ot[dt][nt][0] * inv, ot[dt][nt][1] * inv);
        pk.y = pack2(ot[dt][nt][2] * inv, ot[dt][nt][3] * inv);
        *(uint2*)(Qg + (nt * 16 + l15) * 64 + dt * 16 + kq * 4) = pk;
      }
      if (kq == 0) {
        const int pos = p0 + 32 * wave + nt * 16 + l15;
        const int r_ = pos >> (13 - sh), i_ = pos & (sublen - 1);
        const int s = (i_ << sh) + r_;
        p.lse()[((size_t)(b * 8192 + s)) * 24 + g * 8 + h] = (mx[nt] + log2f(sum[nt])) * 0.6931471805599453f;
      }
    }
  }
  __syncthreads();
}


DEVFN bf16x8 ld8_bf(const float* p) {
  const float4 a = *(const float4*)p, b = *(const float4*)(p + 4);
  BF8 r;
  r.u[0] = pack2(a.x, a.y); r.u[1] = pack2(a.z, a.w); r.u[2] = pack2(b.x, b.y); r.u[3] = pack2(b.z, b.w);
  return r.v;
}
DEVFN void ld8_bf_split(const float* p, bf16x8& hi, bf16x8& lo) {
  const float4 a = *(const float4*)p, b = *(const float4*)(p + 4);
  const float v[8] = {a.x, a.y, a.z, a.w, b.x, b.y, b.z, b.w};
  BF8 h, l;
#pragma unroll
  for (int e = 0; e < 4; ++e) {
    h.u[e] = pack2(v[2 * e], v[2 * e + 1]);
    const float r0 = v[2 * e] - __uint_as_float(h.u[e] << 16), r1 = v[2 * e + 1] - __uint_as_float(h.u[e] & 0xffff0000u);
    l.u[e] = pack2(r0, r1);
  }
  hi = h.v; lo = l.v;
}

template <int J, int I4> struct SolveInner {
  static DEVFN void run(float (&X)[64], const float* amT, float xj) {
    if (I4 + 3 > J) {
      const float4 a = *(const float4*)(amT + J * 68 + I4);
      if (I4 + 0 > J) X[I4 + 0] -= a.x * xj;
      if (I4 + 1 > J) X[I4 + 1] -= a.y * xj;
      if (I4 + 2 > J) X[I4 + 2] -= a.z * xj;
      if (I4 + 3 > J) X[I4 + 3] -= a.w * xj;
    }
    SolveInner<J, I4 + 4>::run(X, amT, xj);
  }
};
template <int J> struct SolveInner<J, 64> { static DEVFN void run(float (&)[64], const float*, float) {} };
template <int J> struct SolveOuter {
  static DEVFN void run(float (&X)[64], const float* amT) {
    SolveInner<J, ((J + 1) / 4) * 4>::run(X, amT, X[J]);
    if ((J & 3) == 3) __builtin_amdgcn_sched_barrier(0);
    SolveOuter<J + 1>::run(X, amT);
  }
};
template <> struct SolveOuter<63> { static DEVFN void run(float (&)[64], const float*) {} };

DEVFN void phase_chunk(const Params& p, char* smem) {
  float* qs = (float*)smem;
  float* ks = qs + 64 * 68;
  float* vs = ks + 64 * 68;
  float* amT = vs + 64 * 68;
  float* Gs = amT + 64 * 68;
  float* bs = Gs + 64;
  float* eG = bs + 64;
  float* eK = eG + 64;
  float* cwl = eK + 64;
  const bool one_bh = (gridDim.x == 512);
  if (one_bh) {
    const int h0 = blockIdx.x & 7;
    for (int idx = threadIdx.x; idx < 768; idx += NT) {
      const int sel = idx >> 8, j = (idx >> 6) & 3, d = idx & 63;
      cwl[idx] = p.conv_w[j * 1536 + sel * 512 + h0 * 64 + d];
    }
    __syncthreads();
  }
  for (int cit = blockIdx.x; cit < 2048; cit += gridDim.x) {
    int tid = threadIdx.x;
    asm volatile("" : "+v"(tid));
    const int lane = tid & 63, wave = __builtin_amdgcn_readfirstlane(tid >> 6);
    const int kq = lane >> 4, l15 = lane & 15;
    const int ci = one_bh ? ((int)(blockIdx.x & 15) * 128 + (int)(blockIdx.x >> 4) + 32 * (cit >> 9)) : cit;
    const int n = ci & 127, bh = ci >> 7, h = bh & 7, b = bh >> 3;
    const int row0 = b * 8192 + n * 64;
    u16* cb = p.chunk() + (size_t)ci * 24576;
    const float gg0 = p.bg()[(size_t)(row0 + lane) * 16 + 8 + h];
    const float be0 = p.bg()[(size_t)(row0 + lane) * 16 + h];
    {
      const int t = tid >> 2, part = tid & 3;
      BF8 raw[3][4][2];
      float msk[4];
#pragma unroll
      for (int j = 0; j < 4; ++j) {
        const int tok = n * 64 + t - 3 + j;
        msk[j] = tok >= 0 ? 1.f : 0.f;
        const int tokc = tok >= 0 ? tok : 0;
        const u16* src = p.Pg() + (size_t)(b * 8192 + tokc) * 1536 + h * 64 + part * 16;
#pragma unroll
        for (int sel = 0; sel < 3; ++sel) {
          raw[sel][j][0].q = *(const uint4*)(src + sel * 512);
          raw[sel][j][1].q = *(const uint4*)(src + sel * 512 + 8);
        }
      }
#pragma unroll
      for (int sel = 0; sel < 3; ++sel) {
        const int ch = sel * 512 + h * 64 + part * 16;
        float a[16];
#pragma unroll
        for (int d = 0; d < 16; ++d) a[d] = 0.f;
#pragma unroll
        for (int j = 0; j < 4; ++j) {
          const BF8& r0 = raw[sel][j][0];
          const BF8& r1 = raw[sel][j][1];
          const float* cwg = p.conv_w + j * 1536 + ch;
          const float* cws = cwl + (sel * 4 + j) * 64 + part * 16;
#pragma unroll
          for (int d = 0; d < 4; ++d) {
            float4 w4;
            if (one_bh) w4 = *(const float4*)(cws + 4 * d); else w4 = *(const float4*)(cwg + 4 * d);
            const float mj = msk[j];
            const unsigned ua = d < 2 ? r0.u[2 * d] : r1.u[2 * d - 4];
            const unsigned ub = d < 2 ? r0.u[2 * d + 1] : r1.u[2 * d - 3];
            a[4 * d + 0] += (w4.x * mj) * __uint_as_float(ua << 16);
            a[4 * d + 1] += (w4.y * mj) * __uint_as_float(ua & 0xffff0000u);
            a[4 * d + 2] += (w4.z * mj) * __uint_as_float(ub << 16);
            a[4 * d + 3] += (w4.w * mj) * __uint_as_float(ub & 0xffff0000u);
          }
        }
        float ss = 0.f;
#pragma unroll
        for (int d = 0; d < 16; ++d) { a[d] = silu(a[d]); ss += a[d] * a[d]; }
        float sc = 1.f;
        if (sel < 2) {
          ss += __shfl_xor(ss, 1);
          ss += __shfl_xor(ss, 2);
          sc = rsqrtf(ss + EPS) * (sel == 0 ? 0.125f : 1.f);
        }
        float* dst = (sel == 0 ? qs : (sel == 1 ? ks : vs)) + t * 68 + part * 16;
#pragma unroll
        for (int d = 0; d < 4; ++d) *(float4*)(dst + 4 * d) = make_float4(a[4 * d] * sc, a[4 * d + 1] * sc, a[4 * d + 2] * sc, a[4 * d + 3] * sc);
      }
    }
    if (wave == 0) {
      float gg = gg0;
#pragma unroll
      for (int o = 1; o < 64; o <<= 1) { const float v = __shfl_up(gg, o); if (lane >= o) gg += v; }
      const float gl = __shfl(gg, 63);
      Gs[lane] = gg;
      bs[lane] = be0;
      eG[lane] = __expf(gg);
      eK[lane] = __expf(gl - gg);
    }
    __syncthreads();
    {
      bf16x8 akh[2], akl[2], aqf[2];
#pragma unroll
      for (int t = 0; t < 2; ++t) {
        ld8_bf_split(ks + (16 * wave + l15) * 68 + 32 * t + kq * 8, akh[t], akl[t]);
        aqf[t] = ld8_bf(qs + (16 * wave + l15) * 68 + 32 * t + kq * 8);
      }
      u16* At = cb + 8192;
      for (int jt = 0; jt < 4; ++jt) {
        if (jt <= wave) {
          f32x4 cK = f32x4{0.f, 0.f, 0.f, 0.f}, cQ = f32x4{0.f, 0.f, 0.f, 0.f};
#pragma unroll
          for (int t = 0; t < 2; ++t) {
            bf16x8 bh, bl;
            ld8_bf_split(ks + (16 * jt + l15) * 68 + 32 * t + kq * 8, bh, bl);
            cK = MFMA16(akl[t], bh, cK);
            cK = MFMA16(akh[t], bl, cK);
            cK = MFMA16(akh[t], bh, cK);
            cQ = MFMA16(aqf[t], bh, cQ);
          }
          const int j = 16 * jt + l15;
          const float Gj = Gs[j];
          float av[4];
#pragma unroll
          for (int r = 0; r < 4; ++r) {
            const int i = 16 * wave + kq * 4 + r;
            const float e = (j <= i) ? __expf(Gs[i] - Gj) : 0.f;
            av[r] = (j < i) ? bs[i] * cK[r] * e : 0.f;
            At[i * 64 + permk(j)] = f2bf(cQ[r] * e);
          }
          *(float4*)(amT + j * 68 + 16 * wave + kq * 4) = make_float4(av[0], av[1], av[2], av[3]);
        } else {
          const int j = 16 * jt + l15;
#pragma unroll
          for (int r = 0; r < 4; ++r) At[(16 * wave + kq * 4 + r) * 64 + permk(j)] = 0;
        }
      }
    }
    __syncthreads();
    float X[64];
    if (tid < 64) {
#pragma unroll
      for (int i = 0; i < 64; ++i) X[i] = vs[i * 68 + tid] * bs[i];
    } else if (tid < 128) {
#pragma unroll
      for (int i = 0; i < 64; ++i) X[i] = ks[i * 68 + tid - 64] * bs[i] * eG[i];
    } else {
      const int tt = tid - 128;
      u16* Qd = cb + 4096;
      for (int idx = tt; idx < 4096; idx += 128) {
        const int c = idx >> 6, dk = idx & 63;
        Qd[c * 64 + permk(dk)] = f2bf(qs[c * 68 + dk] * eG[c]);
      }
    }
    __syncthreads();
    if (tid < 128) {
      SolveOuter<0>::run(X, amT);
      if (tid < 64) {
        const int v = tid;
        u16* U = cb + 12288;
#pragma unroll
        for (int i = 0; i < 64; ++i) {
          vs[i * 68 + v] = X[i];
          const int mt = i >> 4, kq2 = (i >> 2) & 3, r = i & 3;
          U[((v >> 4) * 64 + kq2 * 16 + (v & 15)) * 16 + mt * 4 + r] = f2bf(X[i]);
        }
      } else {
        const int dk = tid - 64;
        u16* W = cb;
        const int pk = permk(dk);
#pragma unroll
        for (int i = 0; i < 64; ++i) {
          qs[i * 68 + dk] = X[i];
          W[i * 64 + pk] = f2bf(X[i]);
        }
      }
    }
    __syncthreads();
    {
      const float dec = eG[63];
      bf16x8 akd[2];
#pragma unroll
      for (int t = 0; t < 2; ++t) {
        float v[8];
#pragma unroll
        for (int j = 0; j < 8; ++j) {
          const int c = 32 * t + kq * 8 + j;
          v[j] = ks[c * 68 + 16 * wave + l15] * eK[c];
        }
        BF8 r;
#pragma unroll
        for (int e = 0; e < 4; ++e) r.u[e] = pack2(v[2 * e], v[2 * e + 1]);
        akd[t] = r.v;
      }
      u16* Mo = cb + 16384;
      u16* Bo = cb + 20480;
#pragma unroll
      for (int jt = 0; jt < 4; ++jt) {
        f32x4 cM = f32x4{0.f, 0.f, 0.f, 0.f}, cB = f32x4{0.f, 0.f, 0.f, 0.f};
#pragma unroll
        for (int t = 0; t < 2; ++t) {
          BF8 bw, bu;
#pragma unroll
          for (int e = 0; e < 4; ++e) {
            const int c = 32 * t + kq * 8 + 2 * e;
            bw.u[e] = pack2(qs[c * 68 + 16 * jt + l15], qs[(c + 1) * 68 + 16 * jt + l15]);
            bu.u[e] = pack2(vs[c * 68 + 16 * jt + l15], vs[(c + 1) * 68 + 16 * jt + l15]);
          }
          cM = MFMA16(akd[t], bw.v, cM);
          cB = MFMA16(akd[t], bu.v, cB);
        }
        const int col = 16 * jt + l15;
        const int pc = permk(col);
#pragma unroll
        for (int r = 0; r < 4; ++r) {
          const int dkp = 16 * wave + kq * 4 + r;
          const float m = (dkp == col ? dec : 0.f) - cM[r];
          Mo[dkp * 64 + pc] = f2bf(m);
        }
        uint2 pk;
        pk.x = pack2(cB[0], cB[1]); pk.y = pack2(cB[2], cB[3]);
        *(uint2*)(Bo + (jt * 64 + lane) * 16 + wave * 4) = pk;
      }
    }
    __syncthreads();
  }
}

#define GREC_OFF 246415360ull
#define GHALF_OFF 250609664ull

#define SC_LOAD(st, rec, Moff, Boff)                                                        \
  {                                                                                          \
    const u16* cbn_ = (rec);                                                                 \
    _Pragma("unroll") for (int mt = 0; mt < 4; ++mt) {                                       \
      Mf[st][mt * 2 + 0] = *(const bf16x8*)(cbn_ + (Moff) + (mt * 16 + l15) * 64 + kq * 8);  \
      Mf[st][mt * 2 + 1] = *(const bf16x8*)(cbn_ + (Moff) + (mt * 16 + l15) * 64 + 32 + kq * 8); \
    }                                                                                        \
    Bq[st][0].q = *(const uint4*)(cbn_ + (Boff) + (vsl * 64 + lane) * 16);                   \
    Bq[st][1].q = *(const uint4*)(cbn_ + (Boff) + (vsl * 64 + lane) * 16 + 8);               \
  }

DEVFN f32x4 unpack_c(const BF8 (&Bq)[2], int mt) {
  const unsigned u0 = Bq[mt >> 1].u[(mt & 1) * 2], u1 = Bq[mt >> 1].u[(mt & 1) * 2 + 1];
  f32x4 c;
  c[0] = __uint_as_float(u0 << 16); c[1] = __uint_as_float(u0 & 0xffff0000u);
  c[2] = __uint_as_float(u1 << 16); c[3] = __uint_as_float(u1 & 0xffff0000u);
  return c;
}

template <int NS, bool STORE = true>
DEVFN void scan_steps(const u16* rec0, size_t rstride, int Moff, int Boff, bf16x8 (&Sb)[2], u16* sd0, size_t sstride,
                      int vsl, int lane) {
  const int kq = lane >> 4, l15 = lane & 15;
  bf16x8 Mf[4][8];
  BF8 Bq[4][2];
#pragma unroll
  for (int i = 0; i < 4 && i < NS; ++i) SC_LOAD(i, rec0 + (size_t)i * rstride, Moff, Boff)
#pragma unroll
  for (int i = 0; i < NS; ++i) {
    const int st = i & 3;
    f32x4 acc[4];
#pragma unroll
    for (int mt = 0; mt < 4; ++mt) {
      f32x4 c = unpack_c(Bq[st], mt);
      c = MFMA16(Mf[st][mt * 2 + 0], Sb[0], c);
      c = MFMA16(Mf[st][mt * 2 + 1], Sb[1], c);
      acc[mt] = c;
    }
    Sb[0] = pack8(acc[0], acc[1]);
    Sb[1] = pack8(acc[2], acc[3]);
    if (STORE) {
      u16* sd = sd0 + (size_t)i * sstride;
      *(bf16x8*)(sd) = Sb[0];
      *(bf16x8*)(sd + 512) = Sb[1];
    }
    if (i + 4 < NS) SC_LOAD(st, rec0 + (size_t)(i + 4) * rstride, Moff, Boff)
  }
}

typedef unsigned __attribute__((ext_vector_type(4))) u32x4s;
DEVFN void merge_tokens(const Params& p, int wid, int nw, int tk0, int tk1, int lane);
DEVFN void phase_scan_x1(const Params& p, char* smem) {
  const int tid = get_tid(), lane = tid & 63, wave = tid >> 6;
  if (gridDim.x == 512 && blockIdx.x >= 256) {
    merge_tokens(p, (blockIdx.x - 256) * 4 + wave, 1024, 0, 8192, lane);
    return;
  }
  const int kq = lane >> 4, l15 = lane & 15;
  const int vsl = wave;
  u16* grec = (u16*)(p.ws + GREC_OFF);
  for (int task = blockIdx.x; task < 256; task += gridDim.x) {
    const int bh = task >> 4, g = task & 15;
    const u16* rec0 = p.chunk() + (size_t)(bh * 128 + g * 8) * 24576;
    bf16x8 Mb[2], Bb[2];
    {
      BF8 m0, m1, z;
      z.q = make_uint4(0, 0, 0, 0);
      m0.q = z.q; m1.q = z.q;
      const int colr = vsl * 16 + l15;
#pragma unroll
      for (int j = 0; j < 8; ++j) {
        const int dk0 = (j >> 2) * 16 + kq * 4 + (j & 3);
        const unsigned one = 0x3f80u << ((j & 1) * 16);
        if (dk0 == colr) m0.u[j >> 1] |= one;
        if (dk0 + 32 == colr) m1.u[j >> 1] |= one;
      }
      Mb[0] = m0.v; Mb[1] = m1.v; Bb[0] = z.v; Bb[1] = z.v;
    }
    f32x4 aM[4], aB[4];
    u16* lbuf = (u16*)smem;
    const int row_w = tid >> 3, ch_w = tid & 7;
    const int woff = row_w * 64 + ((ch_w ^ ((row_w >> 1) & 7)) << 3);
    u32x4s rm[8][2];
    BF8 rb[8][2];
#pragma unroll
    for (int r = 0; r < 8; ++r) {
      const u16* rec_ = rec0 + (size_t)r * 24576;
      rm[r][0] = *(const u32x4s*)(rec_ + 16384 + tid * 8);
      rm[r][1] = *(const u32x4s*)(rec_ + 16384 + (tid + 256) * 8);
      rb[r][0].q = *(const uint4*)(rec_ + 20480 + (vsl * 64 + lane) * 16);
      rb[r][1].q = *(const uint4*)(rec_ + 20480 + (vsl * 64 + lane) * 16 + 8);
    }
#pragma unroll
    for (int i = 0; i < 8; ++i) {
      u16* lb = lbuf + (i & 1) * 4096;
      *(u32x4s*)(lb + woff) = rm[i][0];
      *(u32x4s*)(lb + woff + 32 * 64) = rm[i][1];
      __syncthreads();
#pragma unroll
      for (int mt = 0; mt < 4; ++mt) {
        const u16* fr = lb + (mt * 16 + l15) * 64;
        const bf16x8 m0 = *(const bf16x8*)(fr + (((0 + kq) ^ ((l15 >> 1) & 7)) << 3));
        const bf16x8 m1 = *(const bf16x8*)(fr + (((4 + kq) ^ ((l15 >> 1) & 7)) << 3));
        f32x4 c = f32x4{0.f, 0.f, 0.f, 0.f};
        c = MFMA16(m0, Mb[0], c);
        c = MFMA16(m1, Mb[1], c);
        aM[mt] = c;
        f32x4 d = unpack_c(rb[i], mt);
        d = MFMA16(m0, Bb[0], d);
        d = MFMA16(m1, Bb[1], d);
        aB[mt] = d;
      }
      Mb[0] = pack8(aM[0], aM[1]); Mb[1] = pack8(aM[2], aM[3]);
      Bb[0] = pack8(aB[0], aB[1]); Bb[1] = pack8(aB[2], aB[3]);
      if (i == 3) {
        u16* gh = (u16*)(p.ws + GHALF_OFF) + (size_t)task * 8192;
        const int pch = permk(vsl * 16 + l15);
#pragma unroll
        for (int mt = 0; mt < 4; ++mt) {
#pragma unroll
          for (int r = 0; r < 4; ++r) gh[(mt * 16 + kq * 4 + r) * 64 + pch] = f2bf(aM[mt][r]);
          uint2 pk;
          pk.x = pack2(aB[mt][0], aB[mt][1]); pk.y = pack2(aB[mt][2], aB[mt][3]);
          *(uint2*)(gh + 4096 + (vsl * 64 + lane) * 16 + mt * 4) = pk;
        }
      }
    }
    u16* gr = grec + (size_t)task * 8192;
    const int pc = permk(vsl * 16 + l15);
#pragma unroll
    for (int mt = 0; mt < 4; ++mt) {
#pragma unroll
      for (int r = 0; r < 4; ++r) gr[(mt * 16 + kq * 4 + r) * 64 + pc] = f2bf(aM[mt][r]);
      uint2 pk;
      pk.x = pack2(aB[mt][0], aB[mt][1]); pk.y = pack2(aB[mt][2], aB[mt][3]);
      *(uint2*)(gr + 4096 + (vsl * 64 + lane) * 16 + mt * 4) = pk;
    }
  }
}

DEVFN void merge_tokens(const Params& p, int wid, int nw, int tk0, int tk1, int lane) {
  u16* out16 = (u16*)p.out;
  for (int tk = tk0 + wid; tk < tk1; tk += nw) {
      const int b = tk >> 13, s = tk & 8191;
      const int hh = lane >> 3, d8 = (lane & 7) * 8;
      float l[3];
      BF8 og[3];
#pragma unroll
      for (int g = 0; g < 3; ++g) {
        const int sh = 2 * g;
        const int pos = ((s & ((1 << sh) - 1)) << (13 - sh)) + (s >> sh);
        og[g].q = *(const uint4*)(p.Qp() + ((size_t)((b * 3 + g) * 8 + hh) * 8192 + pos) * 64 + d8);
        l[g] = p.lse()[(size_t)tk * 24 + g * 8 + hh];
      }
      const float ml = fmaxf(l[0], fmaxf(l[1], l[2]));
      float w[3];
      float den = 0.f;
#pragma unroll
      for (int g = 0; g < 3; ++g) { w[g] = __expf(l[g] - ml); den += w[g]; }
      const float inv = 1.f / den;
      u16* zp = out16 + 16777216 + (size_t)tk * 1024 + hh * 64 + d8;
      BF8 z; z.q = *(const uint4*)zp;
      BF8 res;
#pragma unroll
      for (int i = 0; i < 4; ++i) {
        float o0 = 0.f, o1 = 0.f;
#pragma unroll
        for (int g = 0; g < 3; ++g) {
          o0 += w[g] * __uint_as_float(og[g].u[i] << 16);
          o1 += w[g] * __uint_as_float(og[g].u[i] & 0xffff0000u);
        }
        o0 *= inv * __uint_as_float(z.u[i] << 16);
        o1 *= inv * __uint_as_float(z.u[i] & 0xffff0000u);
        res.u[i] = pack2(o0, o1);
      }
      *(uint4*)zp = res.q;
    }
}

DEVFN void late_transposes(const Params& p, char* smem, int bm, int nbm) {
  float* ts = (float*)smem;
  for (int t = bm; t < 1024; t += nbm) {
    if (t < 512) {
      const int n0 = (112 + (t >> 4)) * 64, k0 = (t & 15) * 64;
      transpose_tile(p.w_in, NWIN, 1024, p.WtIn(), k0, n0, n0 + 16, ts);
    } else if (t < 640) {
      const int u = t - 512, n0 = (u >> 3) * 64, k0 = (u & 7) * 64;
      transpose_tile(p.w_up_a, 1024, 512, p.WtUpA(), k0, n0, n0, ts);
    } else if (t < 768) {
      const int u = t - 640, n0 = (u >> 3) * 64, k0 = (u & 7) * 64;
      transpose_tile(p.w_up_b, 1024, 512, p.WtUpB(), k0, n0, n0, ts);
    } else {
      const int u = t - 768, n0 = (u >> 4) * 64, k0 = (u & 15) * 64;
      transpose_tile(p.w_out, 1024, 1024, p.WtOut(), k0, n0, n0, ts);
    }
  }
}

DEVFN void phase_scan_merge(const Params& p, char* smem) {
  const int tid = get_tid(), lane = tid & 63, wave = tid >> 6;
  if (blockIdx.x < 16) {
    const int ci0 = blockIdx.x * 128;
    const int vsl = wave;
    bf16x8 Sb[2];
    {
      BF8 z; z.q = make_uint4(0, 0, 0, 0);
      Sb[0] = z.v; Sb[1] = z.v;
    }
    u16* sdst = p.Sbuf() + ((size_t)ci0 * 4 + vsl) * 1024 + lane * 8;
    *(bf16x8*)(sdst) = Sb[0];
    *(bf16x8*)(sdst + 512) = Sb[1];
    const u16* grec = (const u16*)(p.ws + GREC_OFF) + (size_t)blockIdx.x * 16 * 8192;
    {
      const int kq = lane >> 4, l15 = lane & 15;
      u16* lbuf = (u16*)smem;
      const int row_w = tid >> 3, ch_w = tid & 7;
      const int woff = row_w * 64 + ((ch_w ^ ((row_w >> 1) & 7)) << 3);
      u32x4s rm[8][2];
      BF8 rb[8][2];
#define X2_LOAD(slot, g)                                                                     \
      {                                                                                      \
        const u16* rec_ = grec + (size_t)(g) * 8192;                                         \
        rm[slot][0] = *(const u32x4s*)(rec_ + tid * 8);                                      \
        rm[slot][1] = *(const u32x4s*)(rec_ + (tid + 256) * 8);                              \
        rb[slot][0].q = *(const uint4*)(rec_ + 4096 + (vsl * 64 + lane) * 16);               \
        rb[slot][1].q = *(const uint4*)(rec_ + 4096 + (vsl * 64 + lane) * 16 + 8);           \
      }
#pragma unroll
      for (int r = 0; r < 8; ++r) X2_LOAD(r, r)
#pragma unroll
      for (int i = 0; i < 15; ++i) {
        const int sl = i & 7;
        u16* lb = lbuf + (i & 1) * 4096;
        *(u32x4s*)(lb + woff) = rm[sl][0];
        *(u32x4s*)(lb + woff + 32 * 64) = rm[sl][1];
        __syncthreads();
        const BF8 b0 = rb[sl][0], b1 = rb[sl][1];
        if (i + 8 < 15) X2_LOAD(sl, i + 8)
        f32x4 acc[4];
#pragma unroll
        for (int mt = 0; mt < 4; ++mt) {
          const u16* fr = lb + (mt * 16 + l15) * 64;
          const bf16x8 m0 = *(const bf16x8*)(fr + (((0 + kq) ^ ((l15 >> 1) & 7)) << 3));
          const bf16x8 m1 = *(const bf16x8*)(fr + (((4 + kq) ^ ((l15 >> 1) & 7)) << 3));
          const BF8& bb = (mt >> 1) ? b1 : b0;
          const unsigned u0 = bb.u[(mt & 1) * 2], u1 = bb.u[(mt & 1) * 2 + 1];
          f32x4 c;
          c[0] = __uint_as_float(u0 << 16); c[1] = __uint_as_float(u0 & 0xffff0000u);
          c[2] = __uint_as_float(u1 << 16); c[3] = __uint_as_float(u1 & 0xffff0000u);
          c = MFMA16(m0, Sb[0], c);
          c = MFMA16(m1, Sb[1], c);
          acc[mt] = c;
        }
        Sb[0] = pack8(acc[0], acc[1]);
        Sb[1] = pack8(acc[2], acc[3]);
        u16* sd = sdst + (size_t)(i + 1) * 8 * 4096;
        *(bf16x8*)(sd) = Sb[0];
        *(bf16x8*)(sd + 512) = Sb[1];
      }
#undef X2_LOAD
    }
  } else {
    late_transposes(p, smem, blockIdx.x - 16, gridDim.x - 16);
    if (gridDim.x == 512) merge_tokens(p, (blockIdx.x - 16) * 4 + wave, (gridDim.x - 16) * 4, 8192, 16384, lane);
    else merge_tokens(p, (blockIdx.x - 16) * 4 + wave, (gridDim.x - 16) * 4, 0, 16384, lane);
  }
}

DEVFN void phase_scan_x3(const Params& p) {
  const int tid = get_tid(), lane = tid & 63, wave = tid >> 6;
  const int vsl = wave;
  for (int task = blockIdx.x; task < 256; task += gridDim.x) {
    const int bh = task >> 4, g = task & 15;
    const int c0 = bh * 128 + g * 8;
    u16* sp = p.Sbuf() + ((size_t)c0 * 4 + vsl) * 1024 + lane * 8;
    bf16x8 Sb[2];
    Sb[0] = *(const bf16x8*)sp;
    Sb[1] = *(const bf16x8*)(sp + 512);
    scan_steps<7>(p.chunk() + (size_t)c0 * 24576, 24576, 16384, 20480, Sb, sp + 4096, 4096, vsl, lane);
  }
}

struct GdnFrag { bf16x8 w[8], q[8], a[8], m[8], sb0, sb1; BF8 u0, u1, b0, b1; };

DEVFN void gdn_load(GdnFrag& f, const Params& p, int ci, int vsl, int lane) {
  const int kq = lane >> 4, l15 = lane & 15;
  const u16* cb = p.chunk() + (size_t)ci * 24576;
  const u16* sp = p.Sbuf() + ((size_t)ci * 4 + vsl) * 1024 + lane * 8;
  f.sb0 = *(const bf16x8*)sp; f.sb1 = *(const bf16x8*)(sp + 512);
  f.u0.q = *(const uint4*)(cb + 12288 + (vsl * 64 + lane) * 16);
  f.u1.q = *(const uint4*)(cb + 12288 + (vsl * 64 + lane) * 16 + 8);
#pragma unroll
  for (int mt = 0; mt < 4; ++mt) {
    const u16* r_ = cb + (mt * 16 + l15) * 64 + kq * 8;
    f.w[mt * 2] = *(const bf16x8*)r_; f.w[mt * 2 + 1] = *(const bf16x8*)(r_ + 32);
    f.q[mt * 2] = *(const bf16x8*)(r_ + 4096); f.q[mt * 2 + 1] = *(const bf16x8*)(r_ + 4096 + 32);
    f.a[mt * 2] = *(const bf16x8*)(r_ + 8192); f.a[mt * 2 + 1] = *(const bf16x8*)(r_ + 8192 + 32);
  }
}

DEVFN void gdn_mfma(const GdnFrag& f, f32x4 (&O)[4]) {
  f32x4 vn[4];
#pragma unroll
  for (int mt = 0; mt < 4; ++mt) {
    f32x4 c = f32x4{0.f, 0.f, 0.f, 0.f};
    c = MFMA16(f.w[mt * 2], f.sb0, c);
    c = MFMA16(f.w[mt * 2 + 1], f.sb1, c);
    const BF8& uu = (mt >> 1) ? f.u1 : f.u0;
    const unsigned u0 = uu.u[(mt & 1) * 2], u1 = uu.u[(mt & 1) * 2 + 1];
    vn[mt][0] = __uint_as_float(u0 << 16) - c[0];
    vn[mt][1] = __uint_as_float(u0 & 0xffff0000u) - c[1];
    vn[mt][2] = __uint_as_float(u1 << 16) - c[2];
    vn[mt][3] = __uint_as_float(u1 & 0xffff0000u) - c[3];
  }
  const bf16x8 Vb0 = pack8(vn[0], vn[1]), Vb1 = pack8(vn[2], vn[3]);
#pragma unroll
  for (int mt = 0; mt < 4; ++mt) {
    f32x4 c = f32x4{0.f, 0.f, 0.f, 0.f};
    c = MFMA16(f.q[mt * 2], f.sb0, c);
    c = MFMA16(f.q[mt * 2 + 1], f.sb1, c);
    c = MFMA16(f.a[mt * 2], Vb0, c);
    c = MFMA16(f.a[mt * 2 + 1], Vb1, c);
    O[mt] = c;
  }
}

DEVFN void gdn_epi(const Params& p, int ci, const f32x4 (&O)[4], float* red, int vsl, int lane) {
  const int kq = lane >> 4, l15 = lane & 15;
  const int n = ci & 127, bh = ci >> 7, h = bh & 7, b = bh >> 3;
  const int row0 = b * 8192 + n * 64;
  const int v = vsl * 16 + l15;
  u16* zbase = (u16*)p.out + 16777216 + (size_t)(row0 + kq * 4) * 1024 + 512 + h * 64 + v;
  u16 zv[16];
#pragma unroll
  for (int mt = 0; mt < 4; ++mt)
#pragma unroll
    for (int r = 0; r < 4; ++r) {
      zv[mt * 4 + r] = zbase[(size_t)(mt * 16 + r) * 1024];
      float ss = O[mt][r] * O[mt][r];
      ss = row16_sum(ss);
      if (l15 == 0) red[vsl * 64 + mt * 16 + kq * 4 + r] = ss;
    }
  __syncthreads();
  const float gw = p.gdn_norm_w[v];
#pragma unroll
  for (int mt = 0; mt < 4; ++mt)
#pragma unroll
    for (int r = 0; r < 4; ++r) {
      const int c = mt * 16 + kq * 4 + r;
      const float tot = red[c] + red[64 + c] + red[128 + c] + red[192 + c];
      const float rstd = rsqrtf(tot * (1.f / 64.f) + EPS);
      zbase[(size_t)(mt * 16 + r) * 1024] = f2bf(O[mt][r] * rstd * gw * bf2f(zv[mt * 4 + r]));
    }
  __syncthreads();
}


DEVFN void gdn_load_mb(GdnFrag& f, const Params& p, int ci, int vsl, int lane) {
  const int kq = lane >> 4, l15 = lane & 15;
  const u16* cb = p.chunk() + (size_t)ci * 24576;
  f.u0.q = *(const uint4*)(cb + 12288 + (vsl * 64 + lane) * 16);
  f.u1.q = *(const uint4*)(cb + 12288 + (vsl * 64 + lane) * 16 + 8);
  f.b0.q = *(const uint4*)(cb + 20480 + (vsl * 64 + lane) * 16);
  f.b1.q = *(const uint4*)(cb + 20480 + (vsl * 64 + lane) * 16 + 8);
#pragma unroll
  for (int mt = 0; mt < 4; ++mt) {
    const u16* r_ = cb + (mt * 16 + l15) * 64 + kq * 8;
    f.w[mt * 2] = *(const bf16x8*)r_; f.w[mt * 2 + 1] = *(const bf16x8*)(r_ + 32);
    f.q[mt * 2] = *(const bf16x8*)(r_ + 4096); f.q[mt * 2 + 1] = *(const bf16x8*)(r_ + 4096 + 32);
    f.a[mt * 2] = *(const bf16x8*)(r_ + 8192); f.a[mt * 2 + 1] = *(const bf16x8*)(r_ + 8192 + 32);
    f.m[mt * 2] = *(const bf16x8*)(r_ + 16384); f.m[mt * 2 + 1] = *(const bf16x8*)(r_ + 16384 + 32);
  }
}
DEVFN void gdn_advance(const GdnFrag& f, bf16x8& s0, bf16x8& s1) {
  f32x4 acc[4];
#pragma unroll
  for (int mt = 0; mt < 4; ++mt) {
    const BF8& bb = (mt >> 1) ? f.b1 : f.b0;
    const unsigned u0 = bb.u[(mt & 1) * 2], u1 = bb.u[(mt & 1) * 2 + 1];
    f32x4 c;
    c[0] = __uint_as_float(u0 << 16); c[1] = __uint_as_float(u0 & 0xffff0000u);
    c[2] = __uint_as_float(u1 << 16); c[3] = __uint_as_float(u1 & 0xffff0000u);
    c = MFMA16(f.m[mt * 2], s0, c);
    c = MFMA16(f.m[mt * 2 + 1], s1, c);
    acc[mt] = c;
  }
  s0 = pack8(acc[0], acc[1]);
  s1 = pack8(acc[2], acc[3]);
}

DEVFN void phase_gdn_out(const Params& p, char* smem) {
  const int tid = get_tid(), lane = tid & 63, wave = tid >> 6;
  float* red = (float*)smem;
  const int vsl = wave;
  if (gridDim.x == 512) {
    const int kq = lane >> 4, l15 = lane & 15;
    const int task = blockIdx.x >> 1, hs = blockIdx.x & 1;
    const int cg = (task >> 4) * 128 + (task & 15) * 8;
    const int c0 = cg + 4 * hs;
    u16* lds0 = (u16*)smem;
    float* red2 = (float*)(smem + 65536);
    const int row_w = tid >> 3, ch_w = tid & 7;
    const int woff = row_w * 64 + ((ch_w ^ ((row_w >> 1) & 7)) << 3);
    const int fsw = (l15 >> 1) & 7;
    u32x4s rg[2][8];
    BF8 ru[2][2], rq[2][2];
#define GO_LOAD(slot, ci_)                                                                    \
    {                                                                                          \
      const u16* cb_ = p.chunk() + (size_t)(ci_) * 24576;                                      \
      rg[slot][0] = *(const u32x4s*)(cb_ + tid * 8);                                           \
      rg[slot][1] = *(const u32x4s*)(cb_ + (tid + 256) * 8);                                   \
      rg[slot][2] = *(const u32x4s*)(cb_ + 4096 + tid * 8);                                    \
      rg[slot][3] = *(const u32x4s*)(cb_ + 4096 + (tid + 256) * 8);                            \
      rg[slot][4] = *(const u32x4s*)(cb_ + 8192 + tid * 8);                                    \
      rg[slot][5] = *(const u32x4s*)(cb_ + 8192 + (tid + 256) * 8);                            \
      rg[slot][6] = *(const u32x4s*)(cb_ + 16384 + tid * 8);                                   \
      rg[slot][7] = *(const u32x4s*)(cb_ + 16384 + (tid + 256) * 8);                           \
      ru[slot][0].q = *(const uint4*)(cb_ + 12288 + (vsl * 64 + lane) * 16);                   \
      ru[slot][1].q = *(const uint4*)(cb_ + 12288 + (vsl * 64 + lane) * 16 + 8);               \
      rq[slot][0].q = *(const uint4*)(cb_ + 20480 + (vsl * 64 + lane) * 16);                   \
      rq[slot][1].q = *(const uint4*)(cb_ + 20480 + (vsl * 64 + lane) * 16 + 8);               \
    }
#define GO_FRAG(lb_, k_, mt_, ks_) (*(const bf16x8*)((lb_) + (k_) * 4096 + ((mt_) * 16 + l15) * 64 + ((((ks_) * 4 + kq) ^ fsw) << 3)))
    GO_LOAD(0, c0)
    GO_LOAD(1, c0 + 1)
    const u16* sp = p.Sbuf() + ((size_t)cg * 4 + vsl) * 1024 + lane * 8;
    bf16x8 Sb[2];
    Sb[0] = *(const bf16x8*)sp;
    Sb[1] = *(const bf16x8*)(sp + 512);
    if (hs) scan_steps<1, false>((const u16*)(p.ws + GHALF_OFF) + (size_t)task * 8192, 0, 0, 4096, Sb, nullptr, 0, vsl, lane);
#pragma unroll
    for (int it = 0; it < 4; ++it) {
      const int sl = it & 1;
      const int ci = c0 + it;
      u16* lb = lds0 + sl * 16384;
#pragma unroll
      for (int k = 0; k < 4; ++k) {
        *(u32x4s*)(lb + k * 4096 + woff) = rg[sl][2 * k];
        *(u32x4s*)(lb + k * 4096 + woff + 32 * 64) = rg[sl][2 * k + 1];
      }
      const BF8 u0 = ru[sl][0], u1 = ru[sl][1], q0 = rq[sl][0], q1 = rq[sl][1];
      __syncthreads();
      if (it + 2 < 4) GO_LOAD(sl, ci + 2)
      f32x4 vn[4];
#pragma unroll
      for (int mt = 0; mt < 4; ++mt) {
        f32x4 c = f32x4{0.f, 0.f, 0.f, 0.f};
        c = MFMA16(GO_FRAG(lb, 0, mt, 0), Sb[0], c);
        c = MFMA16(GO_FRAG(lb, 0, mt, 1), Sb[1], c);
        const BF8& uu = (mt >> 1) ? u1 : u0;
        const unsigned a0 = uu.u[(mt & 1) * 2], a1 = uu.u[(mt & 1) * 2 + 1];
        vn[mt][0] = __uint_as_float(a0 << 16) - c[0];
        vn[mt][1] = __uint_as_float(a0 & 0xffff0000u) - c[1];
        vn[mt][2] = __uint_as_float(a1 << 16) - c[2];
        vn[mt][3] = __uint_as_float(a1 & 0xffff0000u) - c[3];
      }
      const bf16x8 Vb0 = pack8(vn[0], vn[1]), Vb1 = pack8(vn[2], vn[3]);
      f32x4 O[4];
#pragma unroll
      for (int mt = 0; mt < 4; ++mt) {
        f32x4 c = f32x4{0.f, 0.f, 0.f, 0.f};
        c = MFMA16(GO_FRAG(lb, 1, mt, 0), Sb[0], c);
        c = MFMA16(GO_FRAG(lb, 1, mt, 1), Sb[1], c);
        c = MFMA16(GO_FRAG(lb, 2, mt, 0), Vb0, c);
        c = MFMA16(GO_FRAG(lb, 2, mt, 1), Vb1, c);
        O[mt] = c;
      }
      if (it < 3) {
        f32x4 acc[4];
#pragma unroll
        for (int mt = 0; mt < 4; ++mt) {
          const BF8& bb = (mt >> 1) ? q1 : q0;
          const unsigned a0 = bb.u[(mt & 1) * 2], a1 = bb.u[(mt & 1) * 2 + 1];
          f32x4 c;
          c[0] = __uint_as_float(a0 << 16); c[1] = __uint_as_float(a0 & 0xffff0000u);
          c[2] = __uint_as_float(a1 << 16); c[3] = __uint_as_float(a1 & 0xffff0000u);
          c = MFMA16(GO_FRAG(lb, 3, mt, 0), Sb[0], c);
          c = MFMA16(GO_FRAG(lb, 3, mt, 1), Sb[1], c);
          acc[mt] = c;
        }
        Sb[0] = pack8(acc[0], acc[1]);
        Sb[1] = pack8(acc[2], acc[3]);
      }
      gdn_epi(p, ci, O, red2, vsl, lane);
    }
#undef GO_LOAD
#undef GO_FRAG
  } else {
    for (int ci = blockIdx.x; ci < 2048; ci += gridDim.x) {
      GdnFrag f;
      gdn_load(f, p, ci, vsl, lane);
      f32x4 O[4];
      gdn_mfma(f, O);
      gdn_epi(p, ci, O, red, vsl, lane);
    }
  }
}

DEVFN void phase3a(const Params& p, char* smem) {
  u16* out16 = (u16*)p.out;
  u16* T = (u16*)smem;
  for (int t = blockIdx.x; t < 512; t += gridDim.x) {
    int mt_ = t & 63, nt_ = t >> 6;
    if (gridDim.x == 512) {
      const int xcd = blockIdx.x & 7, j = blockIdx.x >> 3;
      mt_ = xcd * 8 + (j & 7);
      nt_ = j >> 3;
    }
    const int row0 = mt_ * 256, n0 = nt_ * 128;
#pragma unroll 1
    for (int half = 0; half < 2; ++half) {
      const int tid = get_tid(), lane = tid & 63, wave = tid >> 6, wr = wave >> 1, wc = wave & 1;
      const int kq = lane >> 4, l15 = lane & 15;
      f32x4 acc[8][4];
      zero_acc(acc);
      gemm_core(out16 + 16777216 + (size_t)row0 * 1024 + half * 512, 1024,
                (half ? p.WtUpB() : p.WtUpA()) + (size_t)n0 * 512, 512, 512, (u16*)smem, acc);
      u16* ytmp = half ? p.Pg() : p.merged();
#pragma unroll
      for (int mt = 0; mt < 8; ++mt)
#pragma unroll
        for (int r = 0; r < 4; ++r) {
          const int lrow = wr * 128 + mt * 16 + kq * 4 + r;
          stage4(T + lrow * 136 + wc * 64 + l15, acc[mt][0][r], acc[mt][1][r], acc[mt][2][r], acc[mt][3][r]);
        }
      __syncthreads();
#pragma unroll
      for (int i = 0; i < 16; ++i) {
        const int id = tid + 256 * i, lrow = id >> 4, pc = id & 15;
        *(uint4*)(ytmp + (size_t)(row0 + lrow) * 1024 + n0 + pc * 8) = *(const uint4*)(T + lrow * 136 + pc * 8);
      }
      __syncthreads();
      zero_acc(acc);
      gemm_core(out16 + (size_t)row0 * 1024, 1024, p.WtIn() + (size_t)(7168 + half * 1024 + n0) * 1024, 1024, 1024, (u16*)smem, acc);
#pragma unroll
      for (int mt = 0; mt < 8; ++mt)
#pragma unroll
        for (int r = 0; r < 4; ++r) {
          const int lrow = wr * 128 + mt * 16 + kq * 4 + r;
          stage4(T + lrow * 136 + wc * 64 + l15, sigm(acc[mt][0][r]), sigm(acc[mt][1][r]), sigm(acc[mt][2][r]), sigm(acc[mt][3][r]));
        }
      __syncthreads();
#pragma unroll 4
      for (int i = 0; i < 16; ++i) {
        const int id = tid + 256 * i, lrow = id >> 4, pc = id & 15;
        BF8 gt, y, m;
        gt.q = *(const uint4*)(T + lrow * 136 + pc * 8);
        y.q = *(const uint4*)(ytmp + (size_t)(row0 + lrow) * 1024 + n0 + pc * 8);
        u16* dst = p.merged() + (size_t)(row0 + lrow) * 1024 + n0 + pc * 8;
        if (half) m.q = *(const uint4*)dst; else m.q = make_uint4(0, 0, 0, 0);
#pragma unroll
        for (int e = 0; e < 4; ++e) {
          const float a0 = __uint_as_float(gt.u[e] << 16) * __uint_as_float(y.u[e] << 16) + __uint_as_float(m.u[e] << 16);
          const float a1 = __uint_as_float(gt.u[e] & 0xffff0000u) * __uint_as_float(y.u[e] & 0xffff0000u) + __uint_as_float(m.u[e] & 0xffff0000u);
          m.u[e] = pack2(a0, a1);
        }
        *(uint4*)dst = m.q;
      }
      __syncthreads();
    }
  }
}

DEVFN void phase3b(const Params& p, char* smem) {
  u16* T = (u16*)smem;
  u16* dl = p.Pg();
  for (int t = blockIdx.x; t < 512; t += gridDim.x) {
    int mt_ = t & 63, nt_ = t >> 6;
    if (gridDim.x == 512) {
      const int xcd = blockIdx.x & 7, j = blockIdx.x >> 3;
      mt_ = xcd * 8 + (j & 7);
      nt_ = j >> 3;
    }
    const int row0 = mt_ * 256, n0 = nt_ * 128;
    f32x4 acc[8][4];
    zero_acc(acc);
    gemm_core(p.merged() + (size_t)row0 * 1024, 1024, p.WtOut() + (size_t)n0 * 1024, 1024, 1024, (u16*)smem, acc);
    const int tid = get_tid(), lane = tid & 63, wave = tid >> 6, wr = wave >> 1, wc = wave & 1;
    const int kq = lane >> 4, l15 = lane & 15;
#pragma unroll
    for (int mt = 0; mt < 8; ++mt)
#pragma unroll
      for (int r = 0; r < 4; ++r) {
        const int lrow = wr * 128 + mt * 16 + kq * 4 + r;
        stage4(T + lrow * 136 + wc * 64 + l15, acc[mt][0][r], acc[mt][1][r], acc[mt][2][r], acc[mt][3][r]);
      }
    __syncthreads();
#pragma unroll
    for (int i = 0; i < 16; ++i) {
      const int id = tid + 256 * i, lrow = id >> 4, pc = id & 15;
      *(uint4*)(dl + (size_t)(row0 + lrow) * 1024 + n0 + pc * 8) = *(const uint4*)(T + lrow * 136 + pc * 8);
    }
    __syncthreads();
  }
}

DEVFN void phase4(const Params& p) {
  const int tid = get_tid(), lane = tid & 63, wave = tid >> 6;
  float4 fw[4];
#pragma unroll
  for (int i4 = 0; i4 < 4; ++i4) fw[i4] = ((const float4*)p.final_norm_w)[lane + 64 * i4];
  const u16* dl = p.Pg();
  for (int row = blockIdx.x * 4 + wave; row < 16384; row += gridDim.x * 4) {
    const float4* xr = (const float4*)(p.x + (size_t)row * 1024);
    const uint2* dr = (const uint2*)(dl + (size_t)row * 1024);
    float4 v[4];
    float ss = 0.f;
#pragma unroll
    for (int i4 = 0; i4 < 4; ++i4) {
      const float4 xv = xr[lane + 64 * i4];
      const uint2 d = dr[lane + 64 * i4];
      float4 t;
      t.x = xv.x + __uint_as_float(d.x << 16); t.y = xv.y + __uint_as_float(d.x & 0xffff0000u);
      t.z = xv.z + __uint_as_float(d.y << 16); t.w = xv.w + __uint_as_float(d.y & 0xffff0000u);
      v[i4] = t;
      ss += t.x * t.x + t.y * t.y + t.z * t.z + t.w * t.w;
    }
#pragma unroll
    for (int o = 32; o >= 16; o >>= 1) ss += __shfl_xor(ss, o);
    ss = row16_sum(ss);
    const float rs = __builtin_amdgcn_rsqf(ss * (1.f / 1024.f) + EPS);
    float4* o = (float4*)(p.out + (size_t)row * 1024);
#pragma unroll
    for (int i4 = 0; i4 < 4; ++i4) {
      float4 t = v[i4];
      t.x *= rs * fw[i4].x; t.y *= rs * fw[i4].y; t.z *= rs * fw[i4].z; t.w *= rs * fw[i4].w;
      o[lane + 64 * i4] = t;
    }
  }
}

#ifndef NO_MEGA
__global__ void __launch_bounds__(256, 2) fwd_megakernel(Params p) {
  __shared__ __attribute__((aligned(16))) char smem[SMEM_BYTES];
  __shared__ uint4 xb_words;
  cg::grid_group grid = cg::this_grid();
  if (threadIdx.x == 0) xb_words = make_uint4(0u, 0u, 0u, 0u);
  __syncthreads();
  if (p.ws == nullptr) grid.sync();
  XcdBarrier xb = xcd_barrier_post((unsigned*)(p.ws + 245956608ull), (volatile LAS unsigned*)&xb_words);
  phase0(p, smem);
  xcd_barrier(xb);
  phase1(p, smem);
  xcd_barrier(xb);
  phase_attn(p, smem);
  xcd_barrier(xb);
  phase_chunk(p, smem);
  xcd_barrier(xb);
  phase_scan_x1(p, smem);
  xcd_barrier(xb);
  phase_scan_merge(p, smem);
  xcd_barrier(xb);
  if (gridDim.x != 512) {
    phase_scan_x3(p);
    xcd_barrier(xb);
  }
  phase_gdn_out(p, smem);
  xcd_barrier(xb);
  phase3a(p, smem);
  xcd_barrier(xb);
  phase3b(p, smem);
  xcd_barrier(xb);
  phase4(p);
}

extern "C" void kernel_launch(void* const* d_in, const int* in_sizes, int n_in, void* d_out, int out_size,
                              void* d_ws, size_t ws_size, hipStream_t stream) {
  static int grid_blocks = 0;
  if (!grid_blocks) {
    int dev = 0, cus = 0, per_cu = 0;
    (void)hipGetDevice(&dev);
    (void)hipDeviceGetAttribute(&cus, hipDeviceAttributeMultiprocessorCount, dev);
    (void)hipOccupancyMaxActiveBlocksPerMultiprocessor(&per_cu, fwd_megakernel, NT, 0);
    if (per_cu > 2) per_cu = 2;
    if (per_cu < 1) per_cu = 1;
    grid_blocks = cus * per_cu;
  }
  Params p{};
  p.x = (const float*)d_in[0]; p.norm_w = (const float*)d_in[1]; p.w_in = (const float*)d_in[2];
  p.conv_w = (const float*)d_in[3]; p.a_log = (const float*)d_in[4]; p.dt_bias = (const float*)d_in[5];
  p.gdn_norm_w = (const float*)d_in[6]; p.w_up_a = (const float*)d_in[7]; p.w_up_b = (const float*)d_in[8];
  p.w_out = (const float*)d_in[9]; p.final_norm_w = (const float*)d_in[10];
  p.out = (float*)d_out;
  p.ws = (char*)d_ws;
  (void)hipMemsetAsync((char*)d_ws + 245956608ull, 0, XCD_BAR_WORDS * sizeof(unsigned), stream);
  void* args[] = {&p};
  hipError_t e = hipLaunchCooperativeKernel((void*)fwd_megakernel, dim3(grid_blocks), dim3(NT), args, 0, stream);
  if (e != hipSuccess) fprintf(stderr, "cooperative launch failed: %s (grid %d)\n", hipGetErrorString(e), grid_blocks);
}
#endif
```
